# Optimizing an MI355X kernel written in HIP

```python
import math
import jax, jax.numpy as jnp
from jax import lax
import numpy as np

D_MODEL = 1024
BATCH = 16
SEQ = 4096
DEPTH = 1

CTX_LEN = 256
GRID_W = 64
HEAD_DIM = 64
RWKV_WIDTH = D_MODEL // 2
RWKV_HEADS = RWKV_WIDTH // HEAD_DIM
DIFF_WIDTH = D_MODEL - RWKV_WIDTH
DIFF_HEADS = DIFF_WIDTH // (2 * HEAD_DIM)
DECAY_LORA = 64
AAA_LORA = 64
GATE_LORA = 128
DIR_LORA = DECAY_LORA + AAA_LORA + GATE_LORA
RWKV_IN = 3 * RWKV_WIDTH + 2 * DIR_LORA
DIFF_IN = 3 * DIFF_WIDTH
IN_WIDTH = RWKV_IN + DIFF_IN
AXIS_DIM = HEAD_DIM // 2
ROPE_THETA = 10000.0
DIFF_SCALE = HEAD_DIM ** -0.5
N_GROUPS = 4
EXPERTS_PER_GROUP = 8
N_EXPERTS = N_GROUPS * EXPERTS_PER_GROUP
TOP_K_IN_GROUP = 2
EXPERT_FF = 512
ROUTE_BLOCK = 128
ATTN_BLOCK = 128
NORM_EPS = 1e-6
GN_EPS = 64e-5
N_MOD = 6

kernel_name = "hybrid_rwkv7_diffattn_hmoe_dit_block"


def _rms(x, w, eps=NORM_EPS):
    xf = x.astype(jnp.float32)
    y = xf * lax.rsqrt(jnp.mean(xf * xf, axis=-1, keepdims=True) + eps)
    return (y * w).astype(x.dtype)


def _axial_rope_tables(seq_len):
    rows = seq_len // GRID_W
    row_id = jnp.repeat(jnp.arange(rows), GRID_W).astype(jnp.float32)
    col_id = jnp.tile(jnp.arange(GRID_W), rows).astype(jnp.float32)
    inv = ROPE_THETA ** (-jnp.arange(0, AXIS_DIM, 2, dtype=jnp.float32) / AXIS_DIM)
    ar = row_id[:, None] * inv
    ac = col_id[:, None] * inv
    ang = jnp.concatenate([ar, ar, ac, ac], axis=-1)
    return jnp.cos(ang), jnp.sin(ang)


def _rotate_half_axial(x):
    x1, x2, x3, x4 = jnp.split(x, 4, axis=-1)
    return jnp.concatenate([-x2, x1, -x4, x3], axis=-1)


def _apply_rope(x, cos, sin):
    c = cos[:, None, None, :]
    s = sin[:, None, None, :]
    return (x * c + _rotate_half_axial(x) * s).astype(x.dtype)


def _centred_shift(z, w):
    zp = jnp.pad(z, ((0, 0), (1, 1), (0, 0)))
    return w[0] * zp[:, :-2] + w[1] * zp[:, 1:-1] + w[2] * zp[:, 2:]


def _rwkv_direction(z, d, w0, w_up, a0, a_up, g_up, k_k, k_a, r_k):
    B, T, _ = z.shape
    heads = lambda t: t.reshape(B, T, RWKV_HEADS, HEAD_DIM)
    r, k, v, lora = jnp.split(z, [RWKV_WIDTH, 2 * RWKV_WIDTH, 3 * RWKV_WIDTH], axis=-1)
    lora_d = lora[..., d * DIR_LORA:(d + 1) * DIR_LORA]
    lw, la, lg = jnp.split(lora_d, [DECAY_LORA, DECAY_LORA + AAA_LORA], axis=-1)
    kkf = heads(k * k_k).astype(jnp.float32)
    kk = kkf / jnp.maximum(jnp.sqrt(jnp.sum(kkf * kkf, axis=-1, keepdims=True)), 1e-12)
    w_raw = (w0[d] + jnp.tanh(lw) @ w_up[d]).astype(jnp.float32)
    w_log = -jax.nn.softplus(-w_raw) - 0.5
    decay = jnp.exp(-jnp.exp(w_log))
    a = jax.nn.sigmoid(a0[d] + la @ a_up[d])
    g = jax.nn.sigmoid(lg) @ g_up[d]
    kd = k * (1 + (a - 1) * k_a)
    rh, kh, vh, ah = heads(r), heads(kd), heads(v), heads(a)
    bonus = jnp.sum(rh * kh * r_k, axis=-1, keepdims=True) * vh
    scan_in = (rh, heads(decay), kh, vh, -kk, kk * ah)
    return scan_in, g, bonus


def _rwkv7_scan(scan_in, s0, reverse, emit):
    xs = tuple(jnp.moveaxis(t.astype(jnp.float32), 1, 0) for t in scan_in)

    def step(S, inp):
        r, w, k, v, a, b = inp
        sa = jnp.einsum('bhij,bhj->bhi', S, a)
        S = S * w[:, :, None, :] + sa[..., None] * b[:, :, None, :] + v[..., None] * k[:, :, None, :]
        y = jnp.einsum('bhij,bhj->bhi', S, r) if emit else None
        return S, y

    S, ys = lax.scan(step, s0, xs, reverse=reverse)
    return S, (jnp.moveaxis(ys, 0, 1) if emit else None)


def _rwkv_readout(y, bonus, g, ln_w, ln_b):
    B, T = y.shape[:2]
    mu = jnp.mean(y, axis=-1, keepdims=True)
    var = jnp.mean(jnp.square(y - mu), axis=-1, keepdims=True)
    yn = ((y - mu) * lax.rsqrt(var + GN_EPS)).reshape(B, T, RWKV_WIDTH) * ln_w + ln_b
    return ((yn + bonus.reshape(B, T, RWKV_WIDTH)) * g).astype(g.dtype)


def _rwkv_group(rx, rc, w0, w_up, a0, a_up, g_up, k_k, k_a, r_k, ln_w, ln_b, need_ctx_out):
    B = rx.shape[0]
    out_x, out_c = None, None
    for d, reverse in ((0, False), (1, True)):
        sx, gx, bx = _rwkv_direction(rx, d, w0, w_up, a0, a_up, g_up, k_k, k_a, r_k)
        sc, gc, bc = _rwkv_direction(rc, d, w0, w_up, a0, a_up, g_up, k_k, k_a, r_k)
        s0 = jnp.zeros((B, RWKV_HEADS, HEAD_DIM, HEAD_DIM), jnp.float32)
        s_ctx, yc = _rwkv7_scan(sc, s0, reverse, need_ctx_out)
        _, yx = _rwkv7_scan(sx, s_ctx, reverse, True)
        ox = _rwkv_readout(yx, bx, gx, ln_w, ln_b)
        out_x = ox if out_x is None else out_x + ox
        if need_ctx_out:
            oc = _rwkv_readout(yc, bc, gc, ln_w, ln_b)
            out_c = oc if out_c is None else out_c + oc
    return out_x, out_c


def _diff_softmax_attend(q, k, v, lam):
    s = jnp.einsum('bhmqd,bhmkd->bhmqk', q, k, preferred_element_type=jnp.float32) * DIFF_SCALE
    p = jax.nn.softmax(s, axis=-1)
    a = p[:, :, 0] - lam * p[:, :, 1]
    return jnp.einsum('bhqk,bhkd->bhqd', a.astype(v.dtype), v)


def _latent_diff_attention(q, k_all, v_all, lam):
    B, H, _, T, dh = q.shape
    nb = T // ATTN_BLOCK
    qb = q.reshape(B, H, 2, nb, ATTN_BLOCK, dh).transpose(3, 0, 1, 2, 4, 5)
    out = lax.map(lambda qq: _diff_softmax_attend(qq, k_all, v_all, lam), qb)
    return out.transpose(1, 0, 3, 2, 4).reshape(B, T, H, 2 * dh)


def _diff_group(dx, dc, cos, sin, q_norm_w, k_norm_w, lam_q1, lam_k1, lam_q2, lam_k2, subln_w,
                lam_init, need_ctx_out):
    def split_heads(z):
        B, T, _ = z.shape
        q, k, v = jnp.split(z, 3, axis=-1)
        q = _rms(q.reshape(B, T, DIFF_HEADS, 2, HEAD_DIM), q_norm_w)
        k = _rms(k.reshape(B, T, DIFF_HEADS, 2, HEAD_DIM), k_norm_w)
        v = v.reshape(B, T, DIFF_HEADS, 2 * HEAD_DIM)
        return q, k, v

    qx, kx, vx = split_heads(dx)
    qc, kc, vc = split_heads(dc)
    qx = _apply_rope(qx, cos, sin)
    kx = _apply_rope(kx, cos, sin)
    to_bh = lambda z: z.transpose(0, 2, 3, 1, 4)
    k_all = jnp.concatenate([to_bh(kc), to_bh(kx)], axis=3)
    v_all = jnp.concatenate([vc, vx], axis=1).transpose(0, 2, 1, 3)
    lam = (jnp.exp(jnp.sum((lam_q1 * lam_k1).astype(jnp.float32)))
           - jnp.exp(jnp.sum((lam_q2 * lam_k2).astype(jnp.float32))) + lam_init)
    B, T = dx.shape[:2]
    ox = _latent_diff_attention(to_bh(qx), k_all, v_all, lam)
    ox = (_rms(ox, subln_w) * (1.0 - lam_init)).reshape(B, T, DIFF_WIDTH)
    oc = None
    if need_ctx_out:
        Cn = dc.shape[1]
        oc = _diff_softmax_attend(to_bh(qc), to_bh(kc), vc.transpose(0, 2, 1, 3), lam)
        oc = (_rms(oc.transpose(0, 2, 1, 3), subln_w) * (1.0 - lam_init)).reshape(B, Cn, DIFF_WIDTH)
    return ox, oc


def _dispatch_experts(hf, experts, weights, w_gate, w_up, w_down):
    n, d = hf.shape
    m = n * TOP_K_IN_GROUP
    flat_e = experts.reshape(m).astype(jnp.int32)
    flat_w = weights.reshape(m)
    order = jnp.argsort(flat_e)
    sorted_e = flat_e[order]
    tok = (order // TOP_K_IN_GROUP).astype(jnp.int32)
    counts = jnp.bincount(flat_e, length=N_EXPERTS)
    padded = (counts + ROUTE_BLOCK - 1) // ROUTE_BLOCK * ROUTE_BLOCK
    pad_end = jnp.cumsum(padded)
    pad_start = pad_end - padded
    start = jnp.cumsum(counts) - counts
    dest = pad_start[sorted_e] + jnp.arange(m, dtype=jnp.int32) - start[sorted_e]
    n_blocks = (m + N_EXPERTS * (ROUTE_BLOCK - 1) + ROUTE_BLOCK - 1) // ROUTE_BLOCK
    n_slots = n_blocks * ROUTE_BLOCK
    slot_tok = jnp.full((n_slots,), n, jnp.int32).at[dest].set(tok)
    slot_w = jnp.zeros((n_slots,), jnp.float32).at[dest].set(flat_w[order])
    block_expert = jnp.minimum(
        jnp.searchsorted(pad_end, jnp.arange(n_blocks, dtype=jnp.int32) * ROUTE_BLOCK, side='right'),
        N_EXPERTS - 1)
    h_pad = jnp.concatenate([hf, jnp.zeros((1, d), hf.dtype)], axis=0)

    def block_fn(args):
        toks, e = args
        xb = h_pad[toks]
        hid = jax.nn.silu(xb @ w_gate[e]) * (xb @ w_up[e])
        return hid @ w_down[e]

    ys = lax.map(block_fn, (slot_tok.reshape(n_blocks, ROUTE_BLOCK), block_expert))
    contrib = ys.reshape(n_slots, d).astype(jnp.float32) * slot_w[:, None]
    out = jnp.zeros((n + 1, d), jnp.float32).at[slot_tok].add(contrib)
    return out[:n].astype(hf.dtype)


def _hier_moe(h, w_group, b_group, w_expert, b_expert, w_gate, w_up, w_down):
    shape = h.shape
    hf = h.reshape(-1, shape[-1])
    n = hf.shape[0]
    g_logits = (hf @ w_group + b_group).astype(jnp.float32)
    g_sel = jnp.argmax(g_logits, axis=-1).astype(jnp.int32)
    g_prob = jnp.take_along_axis(jax.nn.softmax(g_logits, axis=-1), g_sel[:, None], axis=1)
    e_logits = (hf @ w_expert + b_expert).astype(jnp.float32).reshape(n, N_GROUPS, EXPERTS_PER_GROUP)
    e_logits = jnp.take_along_axis(e_logits, g_sel[:, None, None], axis=1)[:, 0]
    top_v, top_i = lax.top_k(e_logits, TOP_K_IN_GROUP)
    weights = jax.nn.softmax(top_v, axis=-1) * g_prob
    experts = g_sel[:, None] * EXPERTS_PER_GROUP + top_i
    y = _dispatch_experts(hf, experts, weights, w_gate, w_up, w_down)
    return y.reshape(shape)


def setup_inputs(seed: int = 0) -> dict:
    key = jax.random.key(seed)
    keys = jax.random.split(key, 40)
    L, D, RW = DEPTH, D_MODEL, RWKV_WIDTH

    def nrm(j, shape, s):
        return s * jax.random.normal(keys[j], shape, jnp.float32)

    return {
        "x": nrm(0, (BATCH, SEQ, D), 1.0),
        "c": nrm(1, (BATCH, D), 1.0),
        "ctx": nrm(2, (BATCH, CTX_LEN, D), 1.0),
        "c_ctx": nrm(3, (D,), 1.0),
        "norm1_w": 1.0 + nrm(4, (L, D), 0.02),
        "norm2_w": 1.0 + nrm(5, (L, D), 0.02),
        "w_mod": nrm(6, (L, D, N_MOD * D), 0.5 * D ** -0.5),
        "b_mod": nrm(7, (L, N_MOD * D), 0.02),
        "w_in": nrm(8, (L, D, IN_WIDTH), D ** -0.5),
        "shift_w": jnp.array([0.3, 1.0, 0.3], jnp.float32)[None, :, None] + nrm(9, (L, 3, RWKV_IN), 0.05),
        "rwkv_w0": jax.random.uniform(keys[10], (L, 2, RW), jnp.float32, -6.0, -1.0),
        "rwkv_w_up": nrm(11, (L, 2, DECAY_LORA, RW), 0.1),
        "rwkv_a0": nrm(12, (L, 2, RW), 0.1),
        "rwkv_a_up": nrm(13, (L, 2, AAA_LORA, RW), 0.1),
        "rwkv_g_up": nrm(14, (L, 2, GATE_LORA, RW), GATE_LORA ** -0.5),
        "rwkv_k_k": 0.85 + nrm(15, (L, RW), 0.02),
        "rwkv_k_a": 1.0 + nrm(16, (L, RW), 0.02),
        "rwkv_r_k": nrm(17, (L, RWKV_HEADS, HEAD_DIM), 0.1),
        "rwkv_ln_w": 1.0 + nrm(18, (L, RW), 0.02),
        "rwkv_ln_b": nrm(19, (L, RW), 0.02),
        "q_norm_w": 1.0 + nrm(20, (L, HEAD_DIM), 0.02),
        "k_norm_w": 1.0 + nrm(21, (L, HEAD_DIM), 0.02),
        "lam_q1": nrm(22, (L, HEAD_DIM), 0.1),
        "lam_k1": nrm(23, (L, HEAD_DIM), 0.1),
        "lam_q2": nrm(24, (L, HEAD_DIM), 0.1),
        "lam_k2": nrm(25, (L, HEAD_DIM), 0.1),
        "subln_w": 1.0 + nrm(26, (L, 2 * HEAD_DIM), 0.02),
        "w_out": nrm(27, (L, D, D), D ** -0.5),
        "w_group": nrm(28, (L, D, N_GROUPS), D ** -0.5),
        "b_group": nrm(29, (L, N_GROUPS), 0.01),
        "w_expert": nrm(30, (L, D, N_EXPERTS), D ** -0.5),
        "b_expert": nrm(31, (L, N_EXPERTS), 0.01),
        "moe_w_gate": nrm(32, (L, N_EXPERTS, D, EXPERT_FF), D ** -0.5),
        "moe_w_up": nrm(33, (L, N_EXPERTS, D, EXPERT_FF), D ** -0.5),
        "moe_w_down": nrm(34, (L, N_EXPERTS, EXPERT_FF, D), EXPERT_FF ** -0.5),
    }


def reference(x, c, ctx, c_ctx, norm1_w, norm2_w, w_mod, b_mod, w_in, shift_w,
              rwkv_w0, rwkv_w_up, rwkv_a0, rwkv_a_up, rwkv_g_up, rwkv_k_k, rwkv_k_a, rwkv_r_k,
              rwkv_ln_w, rwkv_ln_b, q_norm_w, k_norm_w, lam_q1, lam_k1, lam_q2, lam_k2, subln_w,
              w_out, w_group, b_group, w_expert, b_expert, moe_w_gate, moe_w_up, moe_w_down):
    T = x.shape[1]
    cos, sin = _axial_rope_tables(T)
    for i in range(DEPTH):
        last = i == DEPTH - 1
        lam_init = 0.8 - 0.6 * math.exp(-0.3 * i)
        mod_x = jax.nn.silu(c) @ w_mod[i] + b_mod[i]
        mod_c = jax.nn.silu(c_ctx) @ w_mod[i] + b_mod[i]
        sh1, sc1, g1, sh2, sc2, g2 = jnp.split(mod_x[:, None, :], N_MOD, axis=-1)
        csh1, csc1, cg1, csh2, csc2, cg2 = jnp.split(mod_c, N_MOD, axis=-1)

        hx = _rms(x, norm1_w[i]) * (1 + sc1) + sh1
        hc = _rms(ctx, norm1_w[i]) * (1 + csc1) + csh1
        px = hx @ w_in[i]
        pc = hc @ w_in[i]

        rx = _centred_shift(px[..., :RWKV_IN], shift_w[i])
        rc = _centred_shift(pc[..., :RWKV_IN], shift_w[i])
        o_rx, o_rc = _rwkv_group(rx, rc, rwkv_w0[i], rwkv_w_up[i], rwkv_a0[i], rwkv_a_up[i],
                                 rwkv_g_up[i], rwkv_k_k[i], rwkv_k_a[i], rwkv_r_k[i],
                                 rwkv_ln_w[i], rwkv_ln_b[i], not last)
        o_dx, o_dc = _diff_group(px[..., RWKV_IN:], pc[..., RWKV_IN:], cos, sin, q_norm_w[i],
                                 k_norm_w[i], lam_q1[i], lam_k1[i], lam_q2[i], lam_k2[i],
                                 subln_w[i], lam_init, not last)

        x = x + g1 * (jnp.concatenate([o_rx, o_dx], axis=-1) @ w_out[i])
        h2 = _rms(x, norm2_w[i]) * (1 + sc2) + sh2
        x = x + g2 * _hier_moe(h2, w_group[i], b_group[i], w_expert[i], b_expert[i],
                               moe_w_gate[i], moe_w_up[i], moe_w_down[i])
        if not last:
            ctx = ctx + cg1 * (jnp.concatenate([o_rc, o_dc], axis=-1) @ w_out[i])
            hc2 = _rms(ctx, norm2_w[i]) * (1 + csc2) + csh2
            ctx = ctx + cg2 * _hier_moe(hc2, w_group[i], b_group[i], w_expert[i], b_expert[i],
                                        moe_w_gate[i], moe_w_up[i], moe_w_down[i])
    return x
```

```cpp
#include <hip/hip_runtime.h>
#include <hip/hip_cooperative_groups.h>
#include <hip/hip_bf16.h>
#include <cstdio>
#include <cstdint>
namespace cg = cooperative_groups;
namespace pg8 {
#define PG8_LAS __attribute__((address_space(3)))
typedef unsigned short bf16_t;
typedef short bf16x8 __attribute__((ext_vector_type(8)));
typedef float f32x4 __attribute__((ext_vector_type(4)));
typedef unsigned u32x4 __attribute__((ext_vector_type(4)));
typedef int i32x4_t __attribute__((ext_vector_type(4)));
typedef int i32x8_t __attribute__((ext_vector_type(8)));
typedef unsigned u32x4_t __attribute__((ext_vector_type(4)));
constexpr int BM = 256, BK = 64, HALF = 128, HTB = HALF * BK * 2  , STAGE_BYTES = 8 * HTB, NXCD = 8, WGM = 8;

__host__ __device__ __forceinline__ int lds_byte(int r, int c) { const int st = (r >> 4) * 2 + (c >> 5), rr = r & 15, cc = c & 31, ob = rr * 64 + cc * 2; return st * 1024 + (ob ^ (((ob >> 9) & 1) << 5)); }
__host__ __device__ __forceinline__ void stage_rc(int b, int& R, int& C) { const int st = b / 1024, sb = b % 1024, swz = sb ^ (((sb >> 9) & 1) << 5); R = (st >> 1) * 16 + swz / 64; C = (st & 1) * 32 + (swz % 64) / 2; }
__host__ __device__ __forceinline__ int perm32(int rho) { const int n = rho >> 4, i = rho & 15; return 8 * (i >> 2) + 4 * n + (i & 3); }

struct Unit { int pm, pn; int aux = 0; };
struct Gemm { const bf16_t* A; const bf16_t* Bt; int M, N, K; const int* rowmap = nullptr; int wid = 0; };
__device__ __forceinline__ int lane_id() { int l = __builtin_amdgcn_mbcnt_hi(~0u, __builtin_amdgcn_mbcnt_lo(~0u, 0u)); asm volatile("" : "+v"(l)); return l; }
__device__ __forceinline__ int lane_id_rebuilt() { unsigned z = 0u; asm volatile("" : "+v"(z)); return (int)__builtin_amdgcn_mbcnt_hi(~0u, __builtin_amdgcn_mbcnt_lo(~0u, z)); }

struct StaticOrder {
    int nM, nN, nwg, G, c;
    __host__ __device__ void init(int M, int N, int G_, int c_) { nM = M / BM; nN = N / BM; nwg = nM * nN; G = G_; c = c_; }
    __host__ __device__ bool next(int i, Unit& u) const {
        const long L = (long)i * G + c; if (L >= nwg) return false;
        int wgid = (int)L; { const int q = nwg / NXCD, r = nwg % NXCD, xcd = wgid % NXCD, off = wgid / NXCD; wgid = (xcd < r ? xcd * (q + 1) : r * (q + 1) + (xcd - r) * q) + off; }
        const int nig = WGM * nN, gid = wgid / nig, fm = gid * WGM, gsz = (nM - fm) < WGM ? (nM - fm) : WGM;
        u.pm = fm + ((wgid % nig) % gsz); u.pn = (wgid % nig) / gsz; return true;
    }
    __device__ __forceinline__ void a_ready(const Unit&) const {}
    __device__ __forceinline__ void done(const Unit&) const {}
};

__device__ __forceinline__ unsigned cvt_pk_bf16(float lo, float hi) { unsigned r; asm volatile("v_cvt_pk_bf16_f32 %0, %1, %2" : "=v"(r) : "v"(lo), "v"(hi)); return r; }
typedef float f32x2 __attribute__((ext_vector_type(2)));
__device__ __forceinline__ f32x2 gelu_pk(f32x2 v) {
    const f32x2 av = __builtin_elementwise_abs(v), d = av * 0.2316418882f + 1.0f;
    f32x2 t; t.x = __builtin_amdgcn_rcpf(d.x); t.y = __builtin_amdgcn_rcpf(d.y);
    f32x2 q = t * 0.5307027145f + (-0.7265760135f); q = q * t + 0.7107068705f; q = q * t + (-0.142248368f); q = q * t + 0.127414796f; q = q * t;
    const f32x2 s = (v * v) * (-0.72134752044f);
    f32x2 e; e.x = __builtin_amdgcn_exp2f(s.x); e.y = __builtin_amdgcn_exp2f(s.y);
    const f32x2 m = v * (q * e), r = v - m;
    f32x2 o; o.x = v.x < 0.f ? m.x : r.x; o.y = v.y < 0.f ? m.y : r.y; return o;
}

template <int ACT  > struct EpiBf16 {
    static constexpr bool PERM = true, AFTER_DRAIN = false; static_assert(ACT == 0 || ACT == 1, "EpiBf16: ACT is 0 (none) or 1 (gelu_pk)");
    bf16_t* O; int ldc; const float* bias; int split_cols; size_t split_stride; float scale0; float gscale = 1.f;
    __device__ __forceinline__ void operator()(const f32x4 (&acc)[2][2][4][2], const Unit& u, int wr, int wc, int fr, int fq) const {
        const int row0 = u.pm * BM + wr * 64 + fr; int colt = u.pn * BM; bf16_t* base = O;
        float sc = 1.f; if (split_cols) { const int t = colt / split_cols; base += (size_t)t * split_stride; colt -= t * split_cols; if (t == 0) sc = scale0; } sc *= gscale;
        const int col0 = colt + wc * 32 + 8 * fq, bcol0 = u.pn * BM + wc * 32 + 8 * fq;
        f32x4 bv[2][2];
#pragma unroll
        for (int bj = 0; bj < 2; ++bj)
#pragma unroll
            for (int n = 0; n < 2; ++n) bv[bj][n] = bias ? *(const f32x4*)(bias + bcol0 + bj * HALF + 4 * n) : (f32x4){0.f, 0.f, 0.f, 0.f};
#pragma unroll
        for (int ai = 0; ai < 2; ++ai)
#pragma unroll
            for (int m = 0; m < 4; ++m) { bf16_t* rowp = base + (size_t)(row0 + ai * HALF + m * 16) * ldc + col0;
#pragma unroll
                for (int bj = 0; bj < 2; ++bj) { f32x4 v0 = acc[ai][bj][m][0] + bv[bj][0], v1 = acc[ai][bj][m][1] + bv[bj][1];
                    if (ACT == 1) { f32x2 a = gelu_pk((f32x2){v0[0], v0[1]}), b = gelu_pk((f32x2){v0[2], v0[3]}), c = gelu_pk((f32x2){v1[0], v1[1]}), d = gelu_pk((f32x2){v1[2], v1[3]});
                        v0 = (f32x4){a.x, a.y, b.x, b.y}; v1 = (f32x4){c.x, c.y, d.x, d.y}; }
                    v0 = v0 * sc; v1 = v1 * sc; u32x4 w; w.x = cvt_pk_bf16(v0[0], v0[1]); w.y = cvt_pk_bf16(v0[2], v0[3]); w.z = cvt_pk_bf16(v1[0], v1[1]); w.w = cvt_pk_bf16(v1[2], v1[3]);
                    *(u32x4*)(rowp + bj * HALF) = w; } }
    }
};
__device__ __forceinline__ void glds_sv(const char* sbase, unsigned voff, unsigned lds_dst) {
    asm volatile("s_mov_b32 m0, %2\n\ts_nop 0\n\tglobal_load_lds_dwordx4 %0, %1" :: "v"(voff), "s"(sbase), "s"(lds_dst) : "memory", "m0"); }
template <class Epi, class Sched, bool ALIGN_EPI = false, bool SP2 = false, bool GATHER = false, bool FP8 = false>
__device__ __forceinline__ void gemm_phase(PG8_LAS unsigned char* lds, const Gemm g, const Sched& S, const Epi& E) {
    const int wid = g.wid, lane = lane_id_rebuilt(), tid = wid * 64 + lane, wr = wid >> 2, wc = wid & 3, fr = lane & 15, fq = lane >> 4;
    const int K = g.K, nt = K / BK;
    static_assert(!GATHER || SP2, "GATHER is implemented on the SP2 loop");
    const size_t kstep = (size_t)(BK * 2);
    const size_t hstep = (size_t)HALF * K * 2;
    unsigned voffA[2], voffB[2], vA0[2], vA1[2];
#pragma unroll
    for (int i = 0; i < 2; ++i) { int R, C; stage_rc(tid * 16 + i * 8192, R, C); const int Rb = Epi::PERM ? ((R & ~31) + perm32(R & 31)) : R;
        voffA[i] = (unsigned)(R * K + C) * 2u; voffB[i] = (unsigned)(Rb * K + C) * 2u; vA0[i] = voffA[i]; vA1[i] = voffA[i] + (unsigned)hstep; }
#define PG8_GSLOT(tg_) ((PG8_LAS u32x4_t*)(lds + STAGE_BYTES + 1024 + (tg_) * 16))
#define PG8_GOFF(u_, o0_, o1_) do { const int tg_ = wid * 64 + lane_id_rebuilt(); _Pragma("unroll") for (int _i = 0; _i < 2; ++_i) { int R_, C_; stage_rc(tg_ * 16 + _i * 8192, R_, C_); \
        const int t0_ = S.map_row((u_), R_), t1_ = S.map_row((u_), HALF + R_); \
        o0_[_i] = (unsigned)(t0_ * K + C_) * 2u; o1_[_i] = (unsigned)(t1_ * K + C_) * 2u; } } while (0)
    const size_t tstep = 2 * hstep;
    const unsigned ldsu = (unsigned)(uintptr_t)lds; const unsigned ldsw = (unsigned)wid * 1024u;
    const int aoff = lds_byte(wr * 64 + fr, fq * 8), boff = lds_byte(wc * 32 + fr, fq * 8);
    const int aoffk0 = aoff, aoffk1 = aoff + 1024;
    const int boffk0 = boff, boffk1 = boff + 1024;
#define PG8_SA(b, h) (((b) * 2 + (h)) * HTB)
#define PG8_SB(b, h) ((4 + (b) * 2 + (h)) * HTB)
#define PG8_STAGE(bufoff, gbase, voff) do { _Pragma("unroll") for (int _i = 0; _i < 2; ++_i) \
        glds_sv((const char*)(gbase), (voff)[_i], ldsu + (unsigned)(bufoff) + ldsw + _i * 8192u); } while (0)
#define PG8_CAT8(lo_, hi_) __builtin_shufflevector(__builtin_bit_cast(i32x4_t, lo_), __builtin_bit_cast(i32x4_t, hi_), 0, 1, 2, 3, 4, 5, 6, 7)
#define PG8_LDA(dst, b, h) do { _Pragma("unroll") for (int m = 0; m < 4; ++m) { \
        if constexpr (FP8) dst##8[m] = PG8_CAT8(*(const PG8_LAS bf16x8*)(lds + PG8_SA(b, h) + aoffk0 + m * 2048), *(const PG8_LAS bf16x8*)(lds + PG8_SA(b, h) + aoffk1 + m * 2048)); \
        else { dst[m][0] = *(const PG8_LAS bf16x8*)(lds + PG8_SA(b, h) + aoffk0 + m * 2048); dst[m][1] = *(const PG8_LAS bf16x8*)(lds + PG8_SA(b, h) + aoffk1 + m * 2048); } } } while (0)
#define PG8_LDB(dst, b, h) do { _Pragma("unroll") for (int n = 0; n < 2; ++n) { \
        if constexpr (FP8) dst##8[n] = PG8_CAT8(*(const PG8_LAS bf16x8*)(lds + PG8_SB(b, h) + boffk0 + n * 2048), *(const PG8_LAS bf16x8*)(lds + PG8_SB(b, h) + boffk1 + n * 2048)); \
        else { dst[n][0] = *(const PG8_LAS bf16x8*)(lds + PG8_SB(b, h) + boffk0 + n * 2048); dst[n][1] = *(const PG8_LAS bf16x8*)(lds + PG8_SB(b, h) + boffk1 + n * 2048); } } } while (0)
#define PG8_MMA(ai, bj, At, Bt) do { __builtin_amdgcn_s_setprio(1); _Pragma("unroll") for (int m = 0; m < 4; ++m) _Pragma("unroll") for (int n = 0; n < 2; ++n) { \
        if constexpr (FP8) acc[ai][bj][m][n] = __builtin_amdgcn_mfma_scale_f32_16x16x128_f8f6f4(Bt##8[n], At##8[m], acc[ai][bj][m][n], 0, 0, 0, 0x7F7F7F7F, 0, 0x7F7F7F7F); \
        else { _Pragma("unroll") for (int k = 0; k < 2; ++k) acc[ai][bj][m][n] = __builtin_amdgcn_mfma_f32_16x16x32_bf16(Bt[n][k], At[m][k], acc[ai][bj][m][n], 0, 0, 0); } } \
        __builtin_amdgcn_s_setprio(0); } while (0)
#define PG8_WAIT_V(n) asm volatile("s_waitcnt vmcnt(" #n ")" ::: "memory")
#define PG8_WAIT_L(n) asm volatile("s_waitcnt lgkmcnt(" #n ")" ::: "memory")
#define PG8_BAR __builtin_amdgcn_s_barrier()
#define PG8_SCHED __builtin_amdgcn_sched_barrier(0)
    Unit cur, nxt; int ui = 0;
    if (!S.next(0, cur)) return;
    f32x4 acc[2][2][4][2];
#pragma unroll
    for (int a = 0; a < 2; ++a)
#pragma unroll
        for (int b = 0; b < 2; ++b)
#pragma unroll
            for (int m = 0; m < 4; ++m)
#pragma unroll
                for (int n = 0; n < 2; ++n) acc[a][b][m][n] = (f32x4){0.f, 0.f, 0.f, 0.f};
    bf16x8 At[4][2], B0[2][2], B1[2][2];
    i32x8_t At8[4], B08[2], B18[2];
    (void)At; (void)B0; (void)B1; (void)At8; (void)B08; (void)B18;
    const char* cA = GATHER ? (const char*)g.A : (const char*)g.A + (size_t)cur.pm * tstep; const char* cB = (const char*)g.Bt + (size_t)cur.pn * tstep;
    if constexpr (GATHER) { PG8_GOFF(cur, vA0, vA1); }
    S.a_ready(cur);
    if constexpr (SP2) {
        PG8_STAGE(PG8_SB(0, 0), cB, voffB); PG8_STAGE(PG8_SB(0, 1), cB + hstep, voffB); PG8_STAGE(PG8_SA(0, 0), cA, vA0); PG8_STAGE(PG8_SA(0, 1), cA, vA1);
        if (wr == 1) PG8_BAR;
        PG8_WAIT_V(2); PG8_BAR;
        PG8_STAGE(PG8_SB(1, 0), cB + kstep, voffB); PG8_STAGE(PG8_SA(1, 0), cA + kstep, vA0); PG8_STAGE(PG8_SB(1, 1), cB + hstep + kstep, voffB);
        PG8_WAIT_V(6); PG8_BAR;
    } else {
        PG8_STAGE(PG8_SB(0, 0), cB, voffB); PG8_STAGE(PG8_SA(0, 0), cA, voffA); PG8_STAGE(PG8_SB(0, 1), cB + hstep, voffB); PG8_STAGE(PG8_SA(0, 1), cA + hstep, voffA);
        if (wr == 1) PG8_BAR;
        PG8_WAIT_V(4); PG8_BAR;
        PG8_STAGE(PG8_SB(1, 0), cB + kstep, voffB); PG8_STAGE(PG8_SA(1, 0), cA + kstep, voffA); PG8_STAGE(PG8_SB(1, 1), cB + hstep + kstep, voffB);
        PG8_WAIT_V(6); PG8_BAR;
    }
    for (;;) {
        const bool has_next = S.next(ui + 1, nxt);
        const char* nA = (has_next && !GATHER) ? (const char*)g.A + (size_t)nxt.pm * tstep : cA;
        if constexpr (GATHER) { if (has_next) { unsigned n0_[2], n1_[2]; PG8_GOFF(nxt, n0_, n1_); const int ts_ = wid * 64 + lane_id_rebuilt(); *PG8_GSLOT(ts_) = (u32x4_t){n0_[0], n0_[1], n1_[0], n1_[1]}; } }
        const char* nB = has_next ? (const char*)g.Bt + (size_t)nxt.pn * tstep : cB;
#pragma unroll 1
        for (int t = 0; t < nt; t += 2) {
            const bool last = (t == nt - 2);
            const char* a1 = cA + (size_t)(t + 1) * kstep;
            const char* a2 = last ? nA : cA + (size_t)(t + 2) * kstep; const char* b2 = last ? nB : cB + (size_t)(t + 2) * kstep;
            const char* a3 = a2 + kstep; const char* b3 = b2 + kstep;
            if (last && has_next) S.a_ready(nxt);

            if constexpr (SP2) {
            PG8_LDB(B0, 0, 0); PG8_LDB(B1, 0, 1); PG8_SCHED; PG8_LDA(At, 0, 0); PG8_STAGE(PG8_SA(1, 1), a1, vA1);
            if constexpr (GATHER) { if (last && has_next) { const int tl_ = wid * 64 + lane_id_rebuilt(); const u32x4_t q_ = *PG8_GSLOT(tl_);
                vA0[0] = q_[0]; vA0[1] = q_[1]; vA1[0] = q_[2]; vA1[1] = q_[3]; } }
            PG8_WAIT_V(8); PG8_WAIT_L(0); PG8_BAR; PG8_MMA(0, 0, At, B0); PG8_MMA(0, 1, At, B1); PG8_BAR; PG8_SCHED;
            PG8_LDA(At, 0, 1); PG8_STAGE(PG8_SB(0, 0), b2, voffB); PG8_STAGE(PG8_SB(0, 1), b2 + hstep, voffB); PG8_STAGE(PG8_SA(0, 0), a2, vA0);
            PG8_WAIT_V(8); PG8_WAIT_L(0); PG8_BAR; PG8_MMA(1, 0, At, B0); PG8_MMA(1, 1, At, B1); PG8_BAR; PG8_SCHED;
            PG8_LDB(B0, 1, 0); PG8_LDB(B1, 1, 1); PG8_SCHED; PG8_LDA(At, 1, 0); PG8_STAGE(PG8_SA(0, 1), a2, vA1);
            PG8_WAIT_V(8); PG8_WAIT_L(0); PG8_BAR; PG8_MMA(0, 0, At, B0); PG8_MMA(0, 1, At, B1); PG8_BAR; PG8_SCHED;
            PG8_LDA(At, 1, 1); PG8_STAGE(PG8_SB(1, 0), b3, voffB); PG8_STAGE(PG8_SB(1, 1), b3 + hstep, voffB); PG8_STAGE(PG8_SA(1, 0), a3, vA0);
            PG8_WAIT_V(8); PG8_WAIT_L(0); PG8_BAR; PG8_MMA(1, 0, At, B0); PG8_MMA(1, 1, At, B1); PG8_BAR; PG8_SCHED;
            } else {
            PG8_LDB(B0, 0, 0); PG8_SCHED; PG8_LDA(At, 0, 0); PG8_STAGE(PG8_SA(1, 1), a1 + hstep, voffA);
            PG8_WAIT_L(8); PG8_BAR; PG8_WAIT_L(0); PG8_MMA(0, 0, At, B0); PG8_BAR; PG8_SCHED;
            PG8_LDB(B1, 0, 1); PG8_STAGE(PG8_SB(0, 0), b2, voffB);
            PG8_BAR; PG8_WAIT_L(0); PG8_MMA(0, 1, At, B1); PG8_BAR;
            PG8_LDA(At, 0, 1); PG8_STAGE(PG8_SA(0, 0), a2, voffA);
            PG8_BAR; PG8_WAIT_L(0); PG8_MMA(1, 0, At, B0); PG8_BAR; PG8_SCHED;
            PG8_STAGE(PG8_SB(0, 1), b2 + hstep, voffB);
            PG8_WAIT_V(6); PG8_BAR; PG8_MMA(1, 1, At, B1); PG8_BAR;
            PG8_LDB(B0, 1, 0); PG8_SCHED; PG8_LDA(At, 1, 0); PG8_STAGE(PG8_SA(0, 1), a2 + hstep, voffA);
            PG8_WAIT_L(8); PG8_BAR; PG8_WAIT_L(0); PG8_MMA(0, 0, At, B0); PG8_BAR; PG8_SCHED;
            PG8_LDB(B1, 1, 1); PG8_STAGE(PG8_SB(1, 0), b3, voffB);
            PG8_BAR; PG8_WAIT_L(0); PG8_MMA(0, 1, At, B1); PG8_BAR;
            PG8_LDA(At, 1, 1); PG8_STAGE(PG8_SA(1, 0), a3, voffA);
            PG8_BAR; PG8_WAIT_L(0); PG8_MMA(1, 0, At, B0); PG8_BAR; PG8_SCHED;
            PG8_STAGE(PG8_SB(1, 1), b3 + hstep, voffB);
            PG8_WAIT_V(6); PG8_BAR; PG8_MMA(1, 1, At, B1); PG8_BAR;
            }
        }
        if constexpr (ALIGN_EPI) { if (wr == 0) PG8_BAR; }
        if constexpr (!Epi::AFTER_DRAIN) { const int l_e = lane_id_rebuilt();
            E(acc, cur, wr, wc, l_e & 15, l_e >> 4); S.done(cur); }
        if (!has_next) break;
#pragma unroll
        for (int a = 0; a < 2; ++a)
#pragma unroll
            for (int b = 0; b < 2; ++b)
#pragma unroll
                for (int m = 0; m < 4; ++m)
#pragma unroll
                    for (int n = 0; n < 2; ++n) acc[a][b][m][n] = (f32x4){0.f, 0.f, 0.f, 0.f};
        cur = nxt; cA = nA; cB = nB; ++ui;
        if constexpr (ALIGN_EPI) { if (wr == 1) PG8_BAR; }
    }
    PG8_WAIT_V(0);
    if constexpr (!ALIGN_EPI) { if (wr == 0) PG8_BAR; }
    PG8_BAR;
    if constexpr (Epi::AFTER_DRAIN) { E.fused(acc, cur, wr, wc, fr, fq, lds, wid, lane); S.done(cur); }
#undef PG8_GOFF
#undef PG8_GSLOT
#undef PG8_SA
#undef PG8_SB
#undef PG8_STAGE
#undef PG8_LDA
#undef PG8_LDB
#undef PG8_MMA
#undef PG8_CAT8
#undef PG8_WAIT_V
#undef PG8_WAIT_L
#undef PG8_BAR
#undef PG8_SCHED
}
}

#define LAS __attribute__((address_space(3)))
typedef unsigned short bf16;
typedef float f32x4 __attribute__((ext_vector_type(4)));
typedef float f32x2 __attribute__((ext_vector_type(2)));
typedef float f32x16 __attribute__((ext_vector_type(16)));
typedef short bf16x8 __attribute__((ext_vector_type(8)));
typedef short s16x4 __attribute__((ext_vector_type(4)));
typedef unsigned u32x4 __attribute__((ext_vector_type(4)));
typedef unsigned u32x2 __attribute__((ext_vector_type(2)));

constexpr int NB = 16, T = 4096, CT = 256, D = 1024;
constexpr int M = NB * T;
constexpr int MC = NB * CT;
constexpr int MT = M + MC;
constexpr int NIN = 3584;
constexpr int NWAVES = 8, NTHR = 512;
constexpr int LDS_BYTES = 159744;
constexpr float NORM_EPS = 1e-6f, GN_EPS = 64e-5f;
constexpr float QSCALE = 0.125f * 1.4426950408889634f;
constexpr int MAXSLOT = 147456;

constexpr size_t MiB = 1u << 20;
constexpr size_t U = (size_t)MT * 512 * 2;
constexpr size_t WS_CTL = 0;
constexpr size_t CTL_BYTES = 65536;
constexpr int CW_BAR = 4096;
constexpr int CNT_STRIDE = 32;
constexpr int MISC_OFF = 159744 - 64;
constexpr size_t WS_MOD = 1 * MiB;
constexpr size_t WS_ROUT = WS_MOD + 512 * 1024;
constexpr size_t WS_WIN = 2 * MiB;
constexpr size_t WS_WOUT = 9 * MiB;
constexpr size_t WS_B1 = 12 * MiB;
constexpr size_t WS_B2 = 76 * MiB;
constexpr size_t WS_HX = 108 * MiB;
constexpr size_t WS_PX = 244 * MiB;
constexpr size_t WS_OCAT = 720 * MiB;
constexpr size_t WS_H2 = 108 * MiB;
constexpr size_t WS_HG = 244 * MiB;
constexpr size_t WS_HID = 540 * MiB;
constexpr float WI_SCALE = 32.f;
constexpr size_t WS_HX8 = 720 * MiB;
constexpr size_t WS_WIN8 = 6 * MiB;
constexpr float WO_SCALE = 32.f;
constexpr size_t WS_VT8 = 180 * MiB;
constexpr size_t WS_STOKG = 620 * MiB;
constexpr int GCAP = 65536;
constexpr size_t WS_TI = 700 * MiB;
constexpr size_t WS_TW = 702 * MiB;
constexpr size_t WS_STOK = 704 * MiB;
constexpr size_t WS_SW = 705 * MiB;
constexpr size_t WS_K8 = 820 * MiB;
constexpr size_t WS_END = 912 * MiB;
static_assert(WS_PX + 7 * U <= WS_OCAT, "px");
static_assert(WS_HX + (size_t)MT * 1024 * 2 <= WS_PX, "hx");
static_assert(WS_HG + (size_t)MAXSLOT * 1024 * 2 <= WS_HID && WS_HID + (size_t)MAXSLOT * 512 * 2 <= WS_TI, "moe");

struct Args {
    const float* in[35];
    float* out; unsigned char* ws;
    int ph_lo, ph_hi;
};

struct Frame {
    LAS unsigned char* lds;
    int tid, lane, wave, G, vcu, bid;
    const float* const* in;
    float* out; unsigned char* ws;
};

__device__ __forceinline__ unsigned pk2(float lo, float hi) { typedef float f2_ __attribute__((ext_vector_type(2))); typedef __bf16 b2_ __attribute__((ext_vector_type(2))); f2_ v = {lo, hi}; return __builtin_bit_cast(unsigned, __builtin_convertvector(v, b2_)); }
__device__ __forceinline__ unsigned f2bf(float f) { return pk2(f, 0.f) & 0xffffu; }
__device__ __forceinline__ unsigned pk4f8(float a, float b, float c, float d) { int p = __builtin_amdgcn_cvt_pk_fp8_f32(a, b, 0, false); p = __builtin_amdgcn_cvt_pk_fp8_f32(c, d, p, true); return (unsigned)p; }
constexpr float W1_SCALE = 32.f, W2_SCALE = 16.f;
__device__ __forceinline__ float bflo(unsigned u) { return __builtin_bit_cast(float, u << 16); }
__device__ __forceinline__ float bfhi(unsigned u) { return __builtin_bit_cast(float, u & 0xffff0000u); }
template <int CTRL> __device__ __forceinline__ float dppf(float v) { return __builtin_bit_cast(float, __builtin_amdgcn_mov_dpp(__builtin_bit_cast(int, v), CTRL, 0xf, 0xf, true)); }
__device__ __forceinline__ float red4(float v) { v += dppf<0xB1>(v); v += dppf<0x4E>(v); return v; }
__device__ __forceinline__ float red8(float v) { v = red4(v); v += dppf<0x141>(v); return v; }
__device__ __forceinline__ float red16(float v) { v = red8(v); v += dppf<0x140>(v); return v; }
__device__ __forceinline__ float rdl(float v, int l) { return __builtin_bit_cast(float, __builtin_amdgcn_readlane(__builtin_bit_cast(int, v), l)); }
__device__ __forceinline__ float wave_sum(float v) { v = red16(v); return (rdl(v, 0) + rdl(v, 16)) + (rdl(v, 32) + rdl(v, 48)); }
__device__ __forceinline__ float frcp(float x) { return __builtin_amdgcn_rcpf(x); }
__device__ __forceinline__ float frsq(float x) { return __builtin_amdgcn_rsqf(x); }
#define LDS_WAIT() asm volatile("s_waitcnt lgkmcnt(0)" ::: "memory")
#define VM_WAIT() asm volatile("s_waitcnt vmcnt(0)" ::: "memory")
__device__ __forceinline__ void glds16(const void* gsrc, unsigned lds_dst) { unsigned keep;
    asm volatile("s_mov_b32 %0, m0\n\ts_mov_b32 m0, %2\n\ts_nop 0\n\tglobal_load_lds_dwordx4 %1, off\n\ts_mov_b32 m0, %0" : "=&s"(keep) : "v"(gsrc), "s"(lds_dst) : "memory"); }
#define WAIT_BAR_ALL() asm volatile("s_waitcnt vmcnt(0) lgkmcnt(0)\n\ts_barrier" ::: "memory")


#define XB_TMO      128
#define XB_XCNT(j)  (256  + 64 * (j))
#define XB_XSUB(j)  (1280 + 64 * (j))
#define XB_XGEN(j)  (2304 + 64 * (j))
#define XB_TOP      3328
#define XB_TOPGEN   3392
#define XCD_BAR_WORDS 3456
#define XB_SPIN_CAP (1u << 22)
__device__ __forceinline__ unsigned xb_ld(unsigned* p)              { return __hip_atomic_load(p, __ATOMIC_RELAXED, __HIP_MEMORY_SCOPE_AGENT); }
__device__ __forceinline__ unsigned xb_add(unsigned* p, unsigned v) { return __hip_atomic_fetch_add(p, v, __ATOMIC_RELAXED, __HIP_MEMORY_SCOPE_AGENT); }
__device__ __forceinline__ unsigned xb_xcc_id() { return (unsigned)__builtin_amdgcn_s_getreg((3 << 11) | 20) & 0xFu; }
#define XB_SPIN(cond, bar) do { unsigned _sp = 0; while (cond) { __builtin_amdgcn_s_sleep(1); \
    if ((++_sp & 255u) == 0u) { if (xb_ld(&(bar)[XB_TMO])) break; if (_sp > XB_SPIN_CAP) { atomicAdd(&(bar)[XB_TMO], 1u); break; } } } } while (0)
struct XcdBarrier { unsigned* bar; unsigned x; volatile LAS unsigned* st; int wave; };
__device__ __forceinline__ XcdBarrier xcd_barrier_post(unsigned* bar, volatile LAS unsigned* st, int wave) {
    XcdBarrier b; b.bar = bar; b.x = xb_xcc_id(); b.st = st; b.wave = wave;
    if (wave == 0 && pg8::lane_id_rebuilt() == 0) (void)xb_add(&bar[XB_XCNT(b.x)], 1u);
    return b;
}
__device__ __forceinline__ void xcd_barrier_complete(unsigned* bar, unsigned x, unsigned& nloc, unsigned& nx) {
    const unsigned G = gridDim.x * gridDim.y * gridDim.z;
    unsigned sum, cnt, mine, sp = 0u;
    for (;;) {
        sum = 0u; cnt = 0u; mine = 0u;
#pragma unroll
        for (unsigned j = 0; j < 16; ++j) { const unsigned c = xb_ld(&bar[XB_XCNT(j)]); sum += c; cnt += (c > 0u) ? 1u : 0u; mine = (j == x) ? c : mine; }
        if (sum == G) break;
        __builtin_amdgcn_s_sleep(1);
        if ((++sp & 255u) == 0u) { if (xb_ld(&bar[XB_TMO])) break; if (sp > XB_SPIN_CAP) { atomicAdd(&bar[XB_TMO], 1u); break; } }
    }
    nloc = mine > 0u ? mine : 1u; nx = cnt > 0u ? cnt : 1u;
}
__device__ __forceinline__ void xcd_barrier(const XcdBarrier& b) {
    asm volatile("s_waitcnt vmcnt(0)" ::: "memory");
    __syncthreads();
    if (b.wave == 0 && pg8::lane_id_rebuilt() == 0) {
        unsigned* bar = b.bar;
        __builtin_amdgcn_s_waitcnt(0);
        unsigned nloc = b.st[0], nx = b.st[1];
        if (nloc == 0u) { xcd_barrier_complete(bar, b.x, nloc, nx); b.st[0] = nloc; b.st[1] = nx; }
        const unsigned old = xb_add(&bar[XB_XSUB(b.x)], 1u);
        const unsigned gen = old / nloc;
        if (old + 1u == (gen + 1u) * nloc) {
            __builtin_amdgcn_fence(__ATOMIC_RELEASE, "agent");
            asm volatile("s_waitcnt vmcnt(0)" ::: "memory");
            const unsigned og = xb_add(&bar[XB_TOP], 1u);
            const unsigned tg = og / nx;
            if (og + 1u == (tg + 1u) * nx) xb_add(&bar[XB_TOPGEN], 1u);
            else XB_SPIN(xb_ld(&bar[XB_TOPGEN]) == tg, bar);
            __builtin_amdgcn_fence(__ATOMIC_ACQUIRE, "agent");
            xb_add(&bar[XB_XGEN(b.x)], 1u);
            asm volatile("s_waitcnt vmcnt(0)" ::: "memory");
        } else {
            XB_SPIN(xb_ld(&bar[XB_XGEN(b.x)]) == gen, bar);
            __builtin_amdgcn_fence(__ATOMIC_ACQUIRE, "agent");
            asm volatile("s_waitcnt vmcnt(0)" ::: "memory");
        }
    }
    __syncthreads();
}

enum { I_X = 0, I_C, I_CTX, I_CCTX, I_N1W, I_N2W, I_WMOD, I_BMOD, I_WIN, I_SHIFT, I_W0, I_WUP, I_A0, I_AUP, I_GUP, I_KK, I_KA, I_RK, I_LNW, I_LNB,
       I_QNW, I_KNW, I_LQ1, I_LK1, I_LQ2, I_LK2, I_SUBLN, I_WOUT, I_WG, I_BG, I_WE, I_BE, I_MG, I_MU, I_MD };

__device__ __forceinline__ void phase_mod(Frame& F) {
    LAS float* sc = (LAS float*)F.lds;
    LAS float* red = (LAS float*)(F.lds + 17 * 1024 * 4);
    const float* c = F.in[I_C]; const float* cctx = F.in[I_CCTX]; const float* wmod = F.in[I_WMOD]; const float* bmod = F.in[I_BMOD];
    float* mod = (float*)(F.ws + WS_MOD);
    for (int cb = F.bid; cb < 256; cb += F.G) {
        { float cv[34]; int tq = F.tid; asm volatile("" : "+v"(tq));
#pragma unroll
          for (int q = 0; q < 34; ++q) cv[q] = q < 32 ? c[tq + q * NTHR] : cctx[tq + (q - 32) * NTHR];
#pragma unroll
          for (int q = 0; q < 34; ++q) sc[tq + q * NTHR] = cv[q] * frcp(1.f + __expf(-cv[q])); }
        __syncthreads();
        int tm = F.tid; asm volatile("" : "+v"(tm));
        const int col = tm % 24, kp = tm / 24;
        if (tm < 504) {
            float acc[17];
#pragma unroll
            for (int r = 0; r < 17; ++r) acc[r] = 0.f;
            float wv[49];
#pragma unroll
            for (int i = 0; i < 49; ++i) { const int k = kp + 21 * i; wv[i] = k < 1024 ? wmod[(size_t)k * 6144 + cb * 24 + col] : 0.f; }
#pragma unroll
            for (int i = 0; i < 49; ++i) { const int k = kp + 21 * i; const int kc = k < 1024 ? k : 1023; const float w = wv[i];
#pragma unroll
                for (int r = 0; r < 17; ++r) acc[r] += sc[r * 1024 + kc] * w; }
#pragma unroll
            for (int r = 0; r < 17; ++r) red[(kp * 17 + r) * 24 + col] = acc[r];
        }
        __syncthreads();
        if (F.tid < 408) { const int r = F.tid / 24, cc = F.tid % 24; float s = 0.f;
            for (int p = 0; p < 21; ++p) s += red[(p * 17 + r) * 24 + cc];
            mod[r * 6144 + cb * 24 + cc] = s + bmod[cb * 24 + cc]; }
        __syncthreads();
    }
}
__device__ __forceinline__ void tr_item(const float* W, int N, int k0, int n0, bf16* dst, bf16* dst2, int pitch, LAS float* scr, int lane) {
    float tv_[32];
#pragma unroll
    for (int i = 0; i < 32; ++i) { const int kk = 2 * i + (lane >> 5); tv_[i] = W[(size_t)(k0 + kk) * N + n0 + (lane & 31)]; }
#pragma unroll
    for (int i = 0; i < 32; ++i) { const int kk = 2 * i + (lane >> 5); scr[kk * 33 + (lane & 31)] = tv_[i]; }
    LDS_WAIT(); asm volatile("" ::: "memory");
    const int c = lane & 7;
#pragma unroll
    for (int j = 0; j < 4; ++j) { const int n = (lane >> 3) + 8 * j; const LAS float* s_ = scr + (8 * c) * 33 + n; float s[8 * 33 - 32];
#pragma unroll
        for (int q = 0; q < 8; ++q) s[q * 33] = s_[q * 33];
        asm volatile("" :: "v"(s[0 * 33]), "v"(s[1 * 33]), "v"(s[2 * 33]), "v"(s[3 * 33]), "v"(s[4 * 33]), "v"(s[5 * 33]), "v"(s[6 * 33]), "v"(s[7 * 33]));
        u32x4 o; o.x = pk2(s[0 * 33], s[1 * 33]); o.y = pk2(s[2 * 33], s[3 * 33]); o.z = pk2(s[4 * 33], s[5 * 33]); o.w = pk2(s[6 * 33], s[7 * 33]);
        *(u32x4*)(dst + (size_t)n * pitch + 8 * c) = o;
        if (dst2) *(u32x4*)(dst2 + (size_t)n * pitch + 8 * c) = o; }
    LDS_WAIT(); asm volatile("" ::: "memory");
}
__device__ __forceinline__ void tr_item8(const float* W, int N, int k0, int n0, unsigned char* dst8, int pitch, float sc, LAS float* scr, int lane) {
    float tv_[32];
#pragma unroll
    for (int i = 0; i < 32; ++i) { const int kk = 2 * i + (lane >> 5); tv_[i] = W[(size_t)(k0 + kk) * N + n0 + (lane & 31)]; }
#pragma unroll
    for (int i = 0; i < 32; ++i) { const int kk = 2 * i + (lane >> 5); scr[kk * 33 + (lane & 31)] = tv_[i]; }
    LDS_WAIT(); asm volatile("" ::: "memory");
    const int n = lane >> 1; unsigned char* d8 = dst8 + (size_t)n * pitch;
#pragma unroll
    for (int q = 0; q < 2; ++q) { const int cc = 2 * (lane & 1) + q; const LAS float* sp_ = scr + (16 * cc) * 33 + n; u32x4 o; float s_[16 * 33 - 32];
#pragma unroll
        for (int r = 0; r < 16; ++r) s_[r * 33] = sp_[r * 33];
        asm volatile("" :: "v"(s_[0 * 33]), "v"(s_[1 * 33]), "v"(s_[2 * 33]), "v"(s_[3 * 33]), "v"(s_[4 * 33]), "v"(s_[5 * 33]), "v"(s_[6 * 33]), "v"(s_[7 * 33]),
                     "v"(s_[8 * 33]), "v"(s_[9 * 33]), "v"(s_[10 * 33]), "v"(s_[11 * 33]), "v"(s_[12 * 33]), "v"(s_[13 * 33]), "v"(s_[14 * 33]), "v"(s_[15 * 33]));
        o.x = pk4f8(s_[0 * 33] * sc, s_[1 * 33] * sc, s_[2 * 33] * sc, s_[3 * 33] * sc); o.y = pk4f8(s_[4 * 33] * sc, s_[5 * 33] * sc, s_[6 * 33] * sc, s_[7 * 33] * sc);
        o.z = pk4f8(s_[8 * 33] * sc, s_[9 * 33] * sc, s_[10 * 33] * sc, s_[11 * 33] * sc); o.w = pk4f8(s_[12 * 33] * sc, s_[13 * 33] * sc, s_[14 * 33] * sc, s_[15 * 33] * sc);
        *(u32x4*)(d8 + 16 * cc) = o; }
    LDS_WAIT(); asm volatile("" ::: "memory");
}
__device__ __forceinline__ void phase_convert(Frame& F) {
    LAS float* scr = (LAS float*)(F.lds + F.wave * 8448);
    const int gw = F.vcu * NWAVES + F.wave, NGW = F.G * NWAVES;
    bf16* WIN = (bf16*)(F.ws + WS_WIN); bf16* WOUT = (bf16*)(F.ws + WS_WOUT); bf16* B1 = (bf16*)(F.ws + WS_B1); bf16* B2 = (bf16*)(F.ws + WS_B2);
    constexpr int I_IN = 16 * 112, I_OUT = 16 * 32, I_GU = 32 * 16 * 16, I_DN = 32 * 8 * 32;
    constexpr int NITEMS = I_IN + I_OUT + 2 * I_GU + I_DN;
    for (int it = gw; it < NITEMS; it += NGW) {
        int r = it;
        if (r < I_IN) { const int kb = r / 112, nb = r % 112;
            if (nb < 64) tr_item(F.in[I_WIN], NIN, 64 * kb, 32 * nb, WIN + (size_t)(32 * nb) * 1024 + 64 * kb, nullptr, 1024, scr, F.lane);
            else tr_item8(F.in[I_WIN], NIN, 64 * kb, 32 * nb, F.ws + WS_WIN8 + (size_t)(32 * nb - 2048) * 1024 + 64 * kb, 1024, WI_SCALE, scr, F.lane);
            continue; } r -= I_IN;
        if (r < I_OUT) { const int kb = r / 32, nb = r % 32, k0 = 64 * kb;
            unsigned char* d1 = (unsigned char*)WOUT + (size_t)(32 * nb) * 1536 + (k0 < 512 ? k0 : k0 + 512);
            tr_item8(F.in[I_WOUT], 1024, k0, 32 * nb, d1, 1536, WO_SCALE, scr, F.lane);
            if (k0 < 512) tr_item8(F.in[I_WOUT], 1024, k0, 32 * nb, d1 + 512, 1536, WO_SCALE, scr, F.lane);
            continue; } r -= I_OUT;
        if (r < 2 * I_GU) { const int up = r >= I_GU; if (up) r -= I_GU; const int e = r >> 8, q = r & 255, kb = q >> 4, nb = q & 15, n0 = 32 * nb;
            const float* W = F.in[up ? I_MU : I_MG] + (size_t)e * 1024 * 512;
            tr_item8(W, 512, 64 * kb, n0, (unsigned char*)B1 + ((size_t)e * 1024 + (n0 >> 7) * 256 + up * 128 + (n0 & 127)) * 1024 + 64 * kb, 1024, W1_SCALE, scr, F.lane); continue; } r -= 2 * I_GU;
        { const int e = r >> 8, q = r & 255, kb = q >> 5, nb = q & 31;
          tr_item8(F.in[I_MD] + (size_t)e * 512 * 1024, 1024, 64 * kb, 32 * nb, (unsigned char*)B2 + ((size_t)e * 1024 + 32 * nb) * 512 + 64 * kb, 512, W2_SCALE, scr, F.lane); }
    }
    float* WR = (float*)(F.ws + WS_ROUT);
    for (int i = F.bid * NTHR + F.tid; i < 36 * 1024; i += F.G * NTHR) { const int e = i >> 10, k = i & 1023;
        WR[i] = e < 4 ? F.in[I_WG][k * 4 + e] : F.in[I_WE][k * 32 + (e - 4)]; }
}

__device__ __forceinline__ void phase_norm1(Frame& F) {
    const int gw = F.vcu * NWAVES + F.wave, NGW = F.G * NWAVES;
    const float* mod = (const float*)(F.ws + WS_MOD); bf16* HX = (bf16*)(F.ws + WS_HX);
    const float* nw = F.in[I_N1W];
    const int per = (MT + NGW - 1) / NGW, r0 = gw * per, r1 = (r0 + per < MT) ? r0 + per : MT;
    f32x4 va[4], vb[4], vc[4], cs4[4], sh4[4]; int cur_m = -1;
#define N1_ROW(r_) ((r_) < M ? F.in[I_X] + (size_t)(r_) * D : F.in[I_CTX] + (size_t)((r_) - M) * D)
#define N1_LOAD(buf_, r_) do { _Pragma("unroll") for (int j = 0; j < 4; ++j) buf_[j] = ((const f32x4*)N1_ROW(r_) + F.lane)[64 * j]; } while (0)
#define N1_PROC(buf_, r_) do { const int rr_ = (r_); const int mrow = rr_ < M ? (rr_ >> 12) : 16; float s = 0.f; \
        if (mrow != cur_m) { cur_m = mrow; _Pragma("unroll") for (int j = 0; j < 4; ++j) { const int k = 256 * j + 4 * F.lane; \
            const f32x4 w = *(const f32x4*)(nw + k), scv = *(const f32x4*)(mod + mrow * 6144 + 1024 + k); sh4[j] = *(const f32x4*)(mod + mrow * 6144 + k); cs4[j] = w * (scv + 1.f); } \
            _Pragma("unroll") for (int j = 0; j < 4; ++j) asm volatile("" : "+v"(sh4[j]), "+v"(cs4[j])); }     \
        _Pragma("unroll") for (int j = 0; j < 4; ++j) s += (buf_[j].x * buf_[j].x + buf_[j].y * buf_[j].y) + (buf_[j].z * buf_[j].z + buf_[j].w * buf_[j].w); \
        const float rinv = 1.f / sqrtf(wave_sum(s) * (1.f / D) + NORM_EPS); \
        unsigned long long* o8 = (unsigned long long*)(HX + (size_t)rr_ * D) + F.lane; unsigned* o4 = (unsigned*)(F.ws + WS_HX8 + (size_t)rr_ * D) + F.lane; \
        _Pragma("unroll") for (int j = 0; j < 4; ++j) { const f32x4 y = (buf_[j] * rinv) * cs4[j] + sh4[j]; \
            o8[64 * j] = (unsigned long long)pk2(y.x, y.y) | ((unsigned long long)pk2(y.z, y.w) << 32); o4[64 * j] = pk4f8(y.x, y.y, y.z, y.w); } } while (0)
    int rr = r0;
    if (r1 - r0 >= 5) {
        N1_LOAD(va, rr); N1_LOAD(vb, rr + 1);
#pragma unroll 1
        for (; rr + 4 < r1; rr += 3) { N1_LOAD(vc, rr + 2); N1_PROC(va, rr); N1_LOAD(va, rr + 3); N1_PROC(vb, rr + 1); N1_LOAD(vb, rr + 4); N1_PROC(vc, rr + 2); }
    } else { if (rr < r1) N1_LOAD(va, rr); if (rr + 1 < r1) N1_LOAD(vb, rr + 1); }
#pragma unroll 1
    for (; rr < r1; rr += 3) {
        if (rr + 2 < r1) N1_LOAD(vc, rr + 2);
        N1_PROC(va, rr);
        if (rr + 1 < r1) { if (rr + 3 < r1) N1_LOAD(va, rr + 3); N1_PROC(vb, rr + 1); }
        if (rr + 2 < r1) { if (rr + 4 < r1) N1_LOAD(vb, rr + 4); N1_PROC(vc, rr + 2); }
    }
#undef N1_ROW
#undef N1_LOAD
#undef N1_PROC
}

__device__ __forceinline__ void ld8(const bf16* p, float (&v)[8]) { const u32x4 u = *(const u32x4*)p;
    v[0] = bflo(u.x); v[1] = bfhi(u.x); v[2] = bflo(u.y); v[3] = bfhi(u.y); v[4] = bflo(u.z); v[5] = bfhi(u.z); v[6] = bflo(u.w); v[7] = bfhi(u.w); }
__device__ __forceinline__ void st8(bf16* p, const float (&v)[8]) { u32x4 u; u.x = pk2(v[0], v[1]); u.y = pk2(v[2], v[3]); u.z = pk2(v[4], v[5]); u.w = pk2(v[6], v[7]); *(u32x4*)p = u; }
__device__ __forceinline__ void phase_prep(Frame& F) {
    LAS f32x2* cs = (LAS f32x2*)F.lds;
    for (int i = F.tid; i < 1024; i += NTHR) { const int pos = i >> 4, fi = i & 15; const float inv = powf(10000.f, -(float)(2 * fi) / 32.f); const float ang = (float)pos * inv;
        cs[i] = (f32x2){cosf(ang), sinf(ang)}; }
    __syncthreads();
    const int gw = F.vcu * NWAVES + F.wave, NGW = F.G * NWAVES, lane = F.lane;
    bf16* PL = (bf16*)(F.ws + WS_PX + 3 * U); bf16* PQ = (bf16*)(F.ws + WS_PX + 4 * U); bf16* PKD = (bf16*)(F.ws + WS_PX + 5 * U); bf16* FEAT = (bf16*)(F.ws + WS_HX);
    const float* sw = F.in[I_SHIFT];
    const int c8 = 8 * lane;
    float s0[8], s1[8], s2[8], qw[8], kw[8];
#pragma unroll
    for (int j = 0; j < 8; ++j) { s0[j] = sw[1536 + c8 + j]; s1[j] = sw[2048 + 1536 + c8 + j]; s2[j] = sw[4096 + 1536 + c8 + j]; qw[j] = F.in[I_QNW][(c8 & 63) + j]; kw[j] = F.in[I_KNW][(c8 & 63) + j]; }
    const int fcat = (c8 & 255) >> 6;
    const int qi = (lane & 7) >> 1;
    const int fi0 = 8 * (lane & 1);
    const int per = (MT + NGW - 1) / NGW, r0 = gw * per, r1 = (r0 + per < MT) ? r0 + per : MT;
#define RAW(P_, r_) (*(const u32x4*)((P_) + (size_t)((r_) < 0 ? 0 : ((r_) > MT - 1 ? MT - 1 : (r_))) * 512 + c8))
#define UNP8(u_, v_) do { v_[0] = bflo(u_.x); v_[1] = bfhi(u_.x); v_[2] = bflo(u_.y); v_[3] = bfhi(u_.y); v_[4] = bflo(u_.z); v_[5] = bfhi(u_.z); v_[6] = bflo(u_.w); v_[7] = bfhi(u_.w); } while (0)
    u32x4 uPrev, uCur, uNext, uNext2, uQK[2], uQ1, uK1;
    if (r0 < r1) { uPrev = RAW(PL, r0 - 1); uCur = RAW(PL, r0); uNext = RAW(PL, r0 + 1); uNext2 = RAW(PL, r0 + 2); uQK[0] = RAW(PQ, r0); uQK[1] = RAW(PKD, r0); uQ1 = RAW(PQ, r0 + 1); uK1 = RAW(PKD, r0 + 1); }
    for (int rr = r0; rr < r1; ++rr) {
        int t, TT; bool isx = rr < M; if (isx) { t = rr & 4095; TT = T; } else { t = (rr - M) & 255; TT = CT; }
        const u32x4 uNext3 = RAW(PL, rr + 3), uQn = RAW(PQ, rr + 2), uKn = RAW(PKD, rr + 2);
        float a[8], b[8], c[8], f[8];
        UNP8(uPrev, a); UNP8(uCur, b); UNP8(uNext, c);
        const float mp = t > 0 ? 1.f : 0.f, mn = t < TT - 1 ? 1.f : 0.f;
#pragma unroll
        for (int j = 0; j < 8; ++j) { const float z = s0[j] * (mp * a[j]) + s1[j] * b[j] + s2[j] * (mn * c[j]);
            const float r_ = frcp(1.f + __expf(fcat == 0 ? -2.f * z : -z));
            f[j] = fcat == 0 ? 2.f * r_ - 1.f : (fcat == 1 ? z : r_); }
        st8(FEAT + (size_t)rr * 512 + c8, f);
#pragma unroll
        for (int which = 0; which < 2; ++which) {
            bf16* P = (which ? PKD : PQ) + (size_t)rr * 512 + c8;
            float v[8]; UNP8(uQK[which], v);
            float ss = 0.f;
#pragma unroll
            for (int j = 0; j < 8; ++j) ss += v[j] * v[j];
            ss = red8(ss);
            const float rinv = frsq(ss * (1.f / 64.f) + NORM_EPS);
#pragma unroll
            for (int j = 0; j < 8; ++j) v[j] = v[j] * rinv * (which ? kw[j] : qw[j]);
            if (isx) {
                const int pos = qi < 2 ? (t >> 6) : (t & 63);
#pragma unroll
                for (int j = 0; j < 8; ++j) { const float p = dppf<0x4E>(v[j]);
                    const f32x2 csv = cs[pos * 16 + fi0 + j];
                    v[j] = (qi & 1) ? v[j] * csv.x + p * csv.y : v[j] * csv.x - p * csv.y; }
            }
            if (!which) {
#pragma unroll
                for (int j = 0; j < 8; ++j) v[j] *= QSCALE; }
            if (!which) st8(P, v);
            else { int bq, key; if (isx) { bq = rr >> 12; key = CT + t; } else { bq = (rr - M) >> 8; key = t; }
                const int hh = c8 >> 7, mm = (c8 >> 6) & 1, dd = c8 & 63;
                *(u32x2*)(F.ws + WS_K8 + ((((size_t)(bq * 4 + hh) * 2 + mm) * 68 + (key >> 6)) * 64 + (key & 63)) * 80 + dd) = (u32x2){pk4f8(v[0], v[1], v[2], v[3]), pk4f8(v[4], v[5], v[6], v[7])}; }
        }
        uPrev = uCur; uCur = uNext; uNext = uNext2; uNext2 = uNext3; uQK[0] = uQ1; uQK[1] = uK1; uQ1 = uQn; uK1 = uKn;
    }
#undef RAW
#undef UNP8
}

namespace scan {
constexpr int TC = 32;
constexpr int O_CL = 0  , O_B = 8192  ,
              O_G = 16384  , O_Y = 32768, O_RHO = 40960  , O_WC_OLD = 41472  , O_WC = 153088  ,
              O_STG = 41984, STG_BYTES = 31744, STG_FEAT = 15360, NSTG = 3  , O_IMGX = O_STG + NSTG * STG_BYTES, O_CT = O_IMGX + 12288;
constexpr int IMG_AT = 0, IMG_RT = 2048, IMG_BT = 4096, IMG_KT = 6144, IMG_QT = 8192, IMG_RTP = 10240, IMG_BH = 12288, IMG_SC = 14336;
constexpr int IMX_KH = 0, IMX_VR = 2048, IMX_AB0 = 4096, IMX_ABR = 5120, IMX_SC = 6144;
constexpr int O_KV1 = 24576  , O_AB1 = 154112  ;
typedef short v4i16_t __attribute__((ext_vector_type(4)));
__device__ __forceinline__ u32x2 trd(const LAS unsigned char* img, int c0, int lane) {
    const int row_ = 4 * (lane >> 4) + ((lane & 15) >> 2);
    const LAS unsigned char* p = img + row_ * 128 + ((((c0 >> 3) + ((lane & 3) >> 1)) ^ (row_ & 7)) << 4) + ((lane & 1) << 3);
    return __builtin_bit_cast(u32x2, __builtin_amdgcn_ds_read_tr16_b64_v4i16((LAS v4i16_t*)p)); }
static_assert(O_KV1 + 8192 <= 32768 && O_AB1 + 4096 <= MISC_OFF && O_WC + 1024 <= O_AB1 && O_CT + 14 * 256 <= O_WC && O_WC + 1024 <= MISC_OFF && O_IMGX + 2 * IMX_SC <= O_CT && 2 * IMG_SC <= STG_BYTES && O_WC_OLD + 512 <= O_STG && O_STG + 32768 <= O_CT, "scan LDS map");
__device__ __forceinline__ int grow(bool isx, int b, int t) { return isx ? b * T + t : M + b * CT + t; }

__device__ __forceinline__ void issue_chunk(Frame& F, int b, int h, int d, bool isx, int t0, int TT, unsigned stg) {
    const bf16* PXB = (const bf16*)(F.ws + WS_PX); const bf16* FEAT = (const bf16*)(F.ws + WS_HX);
    const int lane = F.lane;
#pragma unroll
    for (int pi = 0; pi < 4; ++pi) { const int p = F.wave + 8 * pi;
        if (p < 15) { const int ten = p / 5, rb = p % 5; int j = 8 * rb + (lane >> 3); int t = t0 - 1 + j; t = t < 0 ? 0 : (t > TT - 1 ? TT - 1 : t);
            const bf16* src = PXB + (size_t)ten * (U / 2) + (size_t)grow(isx, b, t) * 512 + h * 64 + 8 * (lane & 7);
            glds16(src, (unsigned)__builtin_amdgcn_readfirstlane(stg + ten * 5120 + rb * 1024)); }
        else if (p < 31) { const int q = p - 15; const int jj = 2 * q + (lane >> 5); const int sd = lane & 31;
            const bf16* src = FEAT + (size_t)grow(isx, b, t0 + jj) * 512 + d * 256 + 8 * (sd ^ (jj & 15));
            glds16(src, (unsigned)__builtin_amdgcn_readfirstlane(stg + STG_FEAT + q * 1024)); }
    }
}

__device__ __forceinline__ void issue_chunk4(Frame& F, int b, int h, int d, bool isx, int t0, int TT, unsigned stg, int w4  ) {
    const bf16* PXB = (const bf16*)(F.ws + WS_PX); const bf16* FEAT = (const bf16*)(F.ws + WS_HX);
    int lane = F.lane; asm volatile("" : "+v"(lane));
#pragma unroll
    for (int pi = 0; pi < 8; ++pi) { const int p = w4 + 4 * pi;
        if (p < 15) { const int ten = p / 5, rb = p % 5; int j = 8 * rb + (lane >> 3); int t = t0 - 1 + j; t = t < 0 ? 0 : (t > TT - 1 ? TT - 1 : t);
            const bf16* src = PXB + (size_t)ten * (U / 2) + (size_t)grow(isx, b, t) * 512 + h * 64 + 8 * (lane & 7);
            glds16(src, (unsigned)__builtin_amdgcn_readfirstlane(stg + ten * 5120 + rb * 1024)); }
        else if (p < 31) { const int q = p - 15; const int jj = 2 * q + (lane >> 5); const int sd = lane & 31;
            const bf16* src = FEAT + (size_t)grow(isx, b, t0 + jj) * 512 + d * 256 + 8 * (sd ^ (jj & 15));
            glds16(src, (unsigned)__builtin_amdgcn_readfirstlane(stg + STG_FEAT + q * 1024)); }
    }
}

__device__ __forceinline__ void run(Frame& F, int sidx) {
    const int b = sidx >> 4, h = (sidx >> 1) & 7, d = sidx & 1;
    const int tid = F.tid, lane = F.lane, wave = F.wave;
    LAS unsigned char* L = F.lds; const unsigned lds0 = (unsigned)(uintptr_t)L;
    const int cq = tid & 15, srow = tid >> 4;
    const int ch0 = h * 64 + 4 * cq;
    const int mt = wave >> 2, nt = wave & 3, n = lane & 15, fq = lane >> 4;
    const int chm = h * 64 + 16 * nt + n;
    bf16x8 bw[2], ba[2], bg[4];
    {
        LAS bf16* WL = (LAS bf16*)(L + O_STG);
        WAIT_BAR_ALL();
        { float wv_[32]; const int nn = lane;
#pragma unroll
          for (int it = 0; it < 32; ++it) { const int k = wave + 8 * it;
              wv_[it] = it < 8 ? F.in[I_WUP][(size_t)(d * 64 + k) * 512 + h * 64 + nn] : it < 16 ? F.in[I_AUP][(size_t)(d * 64 + k - 64) * 512 + h * 64 + nn] : F.in[I_GUP][(size_t)(d * 128 + k - 128) * 512 + h * 64 + nn]; }
#pragma unroll
          for (int it = 0; it < 32; ++it) WL[nn * 256 + wave + 8 * it] = (bf16)f2bf(wv_[it]); }
        LDS_WAIT(); __builtin_amdgcn_s_barrier(); asm volatile("" ::: "memory");
        for (int idx = tid; idx < 14 * 64; idx += NTHR) { const int rw = idx >> 6, cc = idx & 63; float v_;
            if (rw < 9) v_ = F.in[I_SHIFT][(rw % 3) * 2048 + (rw / 3) * 512 + h * 64 + cc];
            else v_ = F.in[rw == 9 ? I_KK : rw == 10 ? I_KA : rw == 11 ? I_RK : rw == 12 ? I_LNW : I_LNB][h * 64 + cc];
            *(LAS float*)(L + O_CT + idx * 4) = v_; }
        const LAS bf16* wp = WL + (16 * nt + n) * 256 + 8 * fq;
#pragma unroll
        for (int ks = 0; ks < 2; ++ks) { bw[ks] = *(const LAS bf16x8*)(wp + 32 * ks); ba[ks] = *(const LAS bf16x8*)(wp + 64 + 32 * ks); }
#pragma unroll
        for (int ks = 0; ks < 4; ++ks) bg[ks] = *(const LAS bf16x8*)(wp + 128 + 32 * ks);
        LDS_WAIT(); __builtin_amdgcn_s_barrier(); asm volatile("" ::: "memory");
    }
    const float w0c = F.in[I_W0][d * 512 + chm], a0c = F.in[I_A0][d * 512 + chm];
    f32x4 Sreg[4];
#pragma unroll
    for (int jt = 0; jt < 4; ++jt) Sreg[jt] = (f32x4){0.f, 0.f, 0.f, 0.f};
    bf16* OC = (bf16*)(F.ws + WS_OCAT);

    constexpr int NCH = (CT + T) / TC;
#define CHUNK_GEOM(ci, isx_, t0_, TT_) bool isx_ = (ci) >= CT / TC; const int TT_ = isx_ ? T : CT; const int lc_ = isx_ ? (ci) - CT / TC : (ci); const int t0_ = d ? TT_ - TC * (lc_ + 1) : TC * lc_;
#define PK4(v) ((u32x2){pk2((v)[0], (v)[1]), pk2((v)[2], (v)[3])})
#define READOUT(ci_, vsr_, gvr_) do { CHUNK_GEOM(ci_, isxr_, t0r_, TTr_) (void)TTr_; if (isxr_) { const int jjr_ = d ? TC - 1 - srow : srow; const int tr_ = t0r_ + jjr_; \
        const f32x4 y_ = *(const LAS f32x4*)(L + O_Y + (srow * 64 + 4 * cq) * 4), gv_ = (gvr_); \
        const float rho_ = *(const LAS float*)(L + O_RHO + ((ci_) & 1) * 256 + srow * 4); \
        const f32x4 lnw_ = *(const LAS f32x4*)(L + O_CT + (12 * 64 + 4 * cq) * 4), lnb_ = *(const LAS f32x4*)(L + O_CT + (13 * 64 + 4 * cq) * 4); \
        asm volatile("" :: "v"(y_), "v"(rho_), "v"(lnw_), "v"(lnb_));        \
        const float mu_ = red16((y_[0] + y_[1]) + (y_[2] + y_[3])) * (1.f / 64.f); const f32x4 dy_ = y_ - mu_; \
        const float var_ = red16((dy_[0] * dy_[0] + dy_[1] * dy_[1]) + (dy_[2] * dy_[2] + dy_[3] * dy_[3])) * (1.f / 64.f); const float rstd_ = frsq(var_ + GN_EPS); \
        f32x4 o_; _Pragma("unroll") for (int c = 0; c < 4; ++c) o_[c] = ((dy_[c] * rstd_) * lnw_[c] + lnb_[c] + rho_ * (vsr_)[c]) * gv_[c]; \
        *(unsigned*)((unsigned char*)OC + (size_t)(b * T + tr_) * 1536 + d * 512 + h * 64 + 4 * cq) = pk4f8(__builtin_amdgcn_fmed3f(o_[0], -448.f, 448.f), __builtin_amdgcn_fmed3f(o_[1], -448.f, 448.f), __builtin_amdgcn_fmed3f(o_[2], -448.f, 448.f), __builtin_amdgcn_fmed3f(o_[3], -448.f, 448.f)); } } while (0)
#define LORA_LOAD(af_, mt_, stg_) do { int ll_ = lane; asm volatile("" : "+v"(ll_)); const int jrow_ = 16 * (mt_) + (ll_ & 15); const LAS unsigned char* fb_ = L + (stg_) + STG_FEAT + jrow_ * 512; \
            _Pragma("unroll") for (int ks = 0; ks < 8; ++ks) af_[ks] = *(const LAS bf16x8*)(fb_ + 16 * ((4 * ks + (ll_ >> 4)) ^ (jrow_ & 15))); } while (0)
#define LORA_TILE(af_, mt_, cj_) do { const int mt = (mt_); int ll_ = lane; asm volatile("" : "+v"(ll_)); const int n = ll_ & 15, fq = ll_ >> 4; \
            f32x4 cw = {0.f, 0.f, 0.f, 0.f}, ca = cw, cg_ = cw; \
            _Pragma("unroll") for (int ks = 0; ks < 2; ++ks) cw = __builtin_amdgcn_mfma_f32_16x16x32_bf16(af_[ks], bw[ks], cw, 0, 0, 0); \
            _Pragma("unroll") for (int ks = 0; ks < 2; ++ks) ca = __builtin_amdgcn_mfma_f32_16x16x32_bf16(af_[2 + ks], ba[ks], ca, 0, 0, 0); \
            _Pragma("unroll") for (int ks = 0; ks < 4; ++ks) cg_ = __builtin_amdgcn_mfma_f32_16x16x32_bf16(af_[4 + ks], bg[ks], cg_, 0, 0, 0); \
            f32x4 lw, pf; \
            _Pragma("unroll") for (int r = 0; r < 4; ++r) lw[r] = -0.60653066f * frcp(1.f + __expf(-(w0c + cw[r]))); \
            if (d == 0) { pf[0] = lw[0]; pf[1] = pf[0] + lw[1]; pf[2] = pf[1] + lw[2]; pf[3] = pf[2] + lw[3]; } else { pf[3] = lw[3]; pf[2] = pf[3] + lw[2]; pf[1] = pf[2] + lw[1]; pf[0] = pf[1] + lw[0]; } \
            const float tot = d == 0 ? pf[3] : pf[0]; \
            const int toti_ = __builtin_bit_cast(int, tot);        \
            const float T0 = __builtin_bit_cast(float, __builtin_amdgcn_ds_bpermute(4 * n, toti_)), T1 = __builtin_bit_cast(float, __builtin_amdgcn_ds_bpermute(4 * (n + 16), toti_)), T2 = __builtin_bit_cast(float, __builtin_amdgcn_ds_bpermute(4 * (n + 32), toti_)), T3 = __builtin_bit_cast(float, __builtin_amdgcn_ds_bpermute(4 * (n + 48), toti_)); \
            const float off = d == 0 ? ((fq > 0 ? T0 : 0.f) + (fq > 1 ? T1 : 0.f)) + (fq > 2 ? T2 : 0.f) : ((fq < 3 ? T3 : 0.f) + (fq < 2 ? T2 : 0.f)) + (fq < 1 ? T1 : 0.f); \
            _Pragma("unroll") for (int r = 0; r < 4; ++r) { const int jj = 16 * mt + 4 * fq + r; const int s_ = d ? TC - 1 - jj : jj; const int o = (s_ * 64 + 16 * nt + n) * 4; \
                *(LAS float*)(L + O_CL + o) = pf[r] + off; \
                *(LAS float*)(L + O_B + o) = frcp(1.f + __expf(-(a0c + ca[r]))); \
                *(LAS float*)(L + O_G + o) = cg_[r]; } \
            if (fq == 0) *(LAS float*)(L + O_WC + ((cj_) & 1) * 512 + ((d ? 1 - mt : mt) * 64 + 16 * nt + n) * 4) = __expf((T0 + T1) + (T2 + T3)); \
        } while (0)
#define IMX_KHP(par_, sc_) ((par_) ? L + O_KV1 + (sc_) * 4096 : L + O_IMGX + (sc_) * IMX_SC + IMX_KH)
#define IMX_VRP(par_, sc_) ((par_) ? L + O_KV1 + (sc_) * 4096 + 2048 : L + O_IMGX + (sc_) * IMX_SC + IMX_VR)
#define IMX_AB0P(par_, sc_) ((par_) ? L + O_AB1 + (sc_) * 2048 : L + O_IMGX + (sc_) * IMX_SC + IMX_AB0)
#define IMX_ABRP(par_, sc_) ((par_) ? L + O_AB1 + (sc_) * 2048 + 1024 : L + O_IMGX + (sc_) * IMX_SC + IMX_ABR)
    const int srow0 = (tid >> 4) & 15;
    f32x4 vsA[2], gA[2], rsA[2], ksA[2], kkA[2], g_p1[2], g_p2[2];
#pragma unroll
    for (int hr = 0; hr < 2; ++hr) { vsA[hr] = (f32x4){0.f, 0.f, 0.f, 0.f}; gA[hr] = vsA[hr]; rsA[hr] = vsA[hr]; ksA[hr] = vsA[hr]; kkA[hr] = vsA[hr]; g_p1[hr] = vsA[hr]; g_p2[hr] = vsA[hr]; }
#define VS_BACK(cj_, hr_) ({ const u32x2 v2_ = *(const LAS u32x2*)(IMX_VRP((cj_) & 1, (hr_)) + srow0 * 128 + (((cq >> 1) ^ (srow0 & 7)) << 4) + ((cq & 1) << 3)); (f32x4){bflo(v2_.x), bfhi(v2_.x), bflo(v2_.y), bfhi(v2_.y)}; })
    { CHUNK_GEOM(0, isx0, t00, TT0) issue_chunk(F, b, h, d, isx0, t00, TT0, lds0 + O_STG); }
    { CHUNK_GEOM(1, isx1, t01, TT1) issue_chunk(F, b, h, d, isx1, t01, TT1, lds0 + O_STG + STG_BYTES); }
    WAIT_BAR_ALL();
    int sbuf = 0;
    for (int ci = 0; ci <= NCH; ++ci) {
        const bool act = ci < NCH; const int cig = act ? ci : NCH - 1;
        CHUNK_GEOM(cig, isx, t0, TT)
        const unsigned stg = O_STG + sbuf * STG_BYTES, stgp = O_STG + (sbuf == 0 ? 2 : sbuf - 1) * STG_BYTES;
        const int pp = (ci - 1) & 1;
        int cqv = cq; asm volatile("" : "+v"(cqv));
        if (wave >= 4) {
            if (ci >= 2) {
#pragma unroll
                for (int hr = 0; hr < 2; ++hr) { const int srow = srow0 + 16 * hr; const f32x4 vsb = VS_BACK(ci - 2, hr); READOUT(ci - 2, vsb, g_p2[hr]); } }
            if (act) {
#pragma unroll
                for (int mtt = 0; mtt < 2; ++mtt) { bf16x8 laf[8]; LORA_LOAD(laf, mtt, stg); LORA_TILE(laf, mtt, ci); }
#pragma unroll
                for (int hr = 0; hr < 2; ++hr) { const int srow = srow0 + 16 * hr;
        {
            const int jj = d ? TC - 1 - srow : srow; const int t = t0 + jj; const int j = jj + 1;
            const LAS unsigned char* sb = L + stg;
            const float mp = t > 0 ? 1.f : 0.f, mn = t < TT - 1 ? 1.f : 0.f;
            float swr[3][4], swk[3][4], swv[3][4];
#pragma unroll
            for (int j3 = 0; j3 < 3; ++j3) { const f32x4 a_ = *(const LAS f32x4*)(L + O_CT + (j3 * 64 + 4 * cqv) * 4), b_ = *(const LAS f32x4*)(L + O_CT + ((3 + j3) * 64 + 4 * cqv) * 4), c_ = *(const LAS f32x4*)(L + O_CT + ((6 + j3) * 64 + 4 * cqv) * 4);
#pragma unroll
                for (int c = 0; c < 4; ++c) { swr[j3][c] = a_[c]; swk[j3][c] = b_[c]; swv[j3][c] = c_[c]; } }
            const f32x4 kk_w = *(const LAS f32x4*)(L + O_CT + (9 * 64 + 4 * cqv) * 4);
#define LD4(ten, row) (*(const LAS u32x2*)(sb + (ten) * 5120 + (row) * 128 + 8 * cq))
#define UNP(u, k) ((k) == 0 ? bflo((u).x) : (k) == 1 ? bfhi((u).x) : (k) == 2 ? bflo((u).y) : bfhi((u).y))
            const u32x2 r0 = LD4(0, j - 1), r1 = LD4(0, j), r2 = LD4(0, j + 1), k0 = LD4(1, j - 1), k1 = LD4(1, j), k2 = LD4(1, j + 1), v0 = LD4(2, j - 1), v1 = LD4(2, j), v2 = LD4(2, j + 1);
            float ss = 0.f;
#pragma unroll
            for (int c = 0; c < 4; ++c) {
                rsA[hr][c] = swr[0][c] * (mp * UNP(r0, c)) + swr[1][c] * UNP(r1, c) + swr[2][c] * (mn * UNP(r2, c));
                ksA[hr][c] = swk[0][c] * (mp * UNP(k0, c)) + swk[1][c] * UNP(k1, c) + swk[2][c] * (mn * UNP(k2, c));
                vsA[hr][c] = swv[0][c] * (mp * UNP(v0, c)) + swv[1][c] * UNP(v1, c) + swv[2][c] * (mn * UNP(v2, c));
                kkA[hr][c] = ksA[hr][c] * kk_w[c]; ss += kkA[hr][c] * kkA[hr][c]; }
            ss = red16(ss);
            kkA[hr] = kkA[hr] * frsq(fmaxf(ss, 1e-24f));
#undef LD4
#undef UNP
        }
                }
            }
        } else {
            if (ci >= 1 && ci + 1 < NCH) { CHUNK_GEOM(ci + 1, isxn, t0n, TTn) issue_chunk4(F, b, h, d, isxn, t0n, TTn, lds0 + O_STG + (sbuf == 2 ? 0 : sbuf + 1) * STG_BYTES, wave); }
            if (ci >= 1)
        {
            int lane = F.lane; asm volatile("" : "+v"(lane));
            const int col = lane & 15, kb = lane >> 4;
            if (wave < 2) {
                const int sc = wave; LAS unsigned char* IMG = L + stgp + sc * IMG_SC; LAS unsigned char* AB0p = IMX_AB0P(pp, sc);
                f32x4 n4 = {0.f, 0.f, 0.f, 0.f}, x4 = n4, nt4 = n4;
                u32x2 a2_[4];
#pragma unroll
                for (int jt = 0; jt < 4; ++jt) a2_[jt] = trd(IMG + IMG_AT, 16 * jt, lane);
#pragma unroll
                for (int ks = 0; ks < 2; ++ks) { const bf16x8 fb = *(const LAS bf16x8*)(IMG + IMG_BT + col * 128 + (((4 * ks + kb) ^ (col & 7)) << 4)), fa = *(const LAS bf16x8*)(IMG + IMG_AT + col * 128 + (((4 * ks + kb) ^ (col & 7)) << 4)),
                                                              fk = *(const LAS bf16x8*)(IMG + IMG_KT + col * 128 + (((4 * ks + kb) ^ (col & 7)) << 4));
                    n4 = __builtin_amdgcn_mfma_f32_16x16x32_bf16(fb, fa, n4, 0, 0, 0);
                    nt4 = __builtin_amdgcn_mfma_f32_16x16x32_bf16(fa, fb, nt4, 0, 0, 0);
                    x4 = __builtin_amdgcn_mfma_f32_16x16x32_bf16(fa, fk, x4, 0, 0, 0); }
#pragma unroll
                for (int c = 0; c < 4; ++c) { if (!(4 * kb + c < col)) n4[c] = 0.f; if (!(col < 4 * kb + c)) { x4[c] = 0.f; nt4[c] = 0.f; } }
#define FRAG4(v) __builtin_bit_cast(bf16x8, (u32x4){pk2((v)[0], (v)[1]), pk2((v)[2], (v)[3]), 0u, 0u})
                const f32x4 z4 = {0.f, 0.f, 0.f, 0.f};
                f32x4 p4 = n4, pt4 = nt4, t4 = n4, tt4 = nt4;
#pragma unroll
                for (int c = 0; c < 4; ++c) if (4 * kb + c == col) { t4[c] += 1.f; tt4[c] += 1.f; }
#pragma unroll
                for (int lvl = 0; lvl < 3; ++lvl) {
                    const bf16x8 fp = FRAG4(p4), fpt = FRAG4(pt4);
                    p4 = __builtin_amdgcn_mfma_f32_16x16x32_bf16(fpt, fp, z4, 0, 0, 0);
                    pt4 = __builtin_amdgcn_mfma_f32_16x16x32_bf16(fp, fpt, z4, 0, 0, 0);
                    const bf16x8 fp2 = FRAG4(p4), ft = FRAG4(t4), ftt = FRAG4(tt4);
                    t4 = __builtin_amdgcn_mfma_f32_16x16x32_bf16(ftt, fp2, t4, 0, 0, 0);
                    if (lvl < 2) tt4 = __builtin_amdgcn_mfma_f32_16x16x32_bf16(fp2, ftt, tt4, 0, 0, 0);
                }
                const bf16x8 Tf = FRAG4(t4);
                const bf16x8 Xf = __builtin_bit_cast(bf16x8, (u32x4){pk2(x4[0], x4[1]), pk2(x4[2], x4[3]), 0u, 0u});
                const f32x4 ab = __builtin_amdgcn_mfma_f32_16x16x32_bf16(Xf, Tf, z4, 0, 0, 0);
                *(LAS u32x4*)(AB0p + (kb * 16 + col) * 16) = (u32x4){0u, 0u, pk2(ab[0], ab[1]), pk2(ab[2], ab[3])};
#pragma unroll
                for (int jt = 0; jt < 4; ++jt) { const u32x2 a2 = a2_[jt];
                    const bf16x8 Af = __builtin_bit_cast(bf16x8, (u32x4){a2.x, a2.y, 0u, 0u});
                    const f32x4 q = __builtin_amdgcn_mfma_f32_16x16x32_bf16(Af, Tf, z4, 0, 0, 0);
                    *(LAS u32x2*)(IMG + IMG_QT + (((jt >> 1) * 4 + kb) * 16 + col) * 16 + (jt & 1) * 8) = (u32x2){pk2(q[0], q[1]), pk2(q[2], q[3])}; }
            } else {
                const int sc = wave - 2; LAS unsigned char* IMG = L + stgp + sc * IMG_SC; LAS unsigned char* ABRp = IMX_ABRP(pp, sc);
#pragma unroll
                for (int which = 0; which < 2; ++which) {
                f32x4 d4 = {0.f, 0.f, 0.f, 0.f};
#pragma unroll
                for (int ks = 0; ks < 2; ++ks) { const bf16x8 fa = *(const LAS bf16x8*)(IMG + (which ? IMG_KT : IMG_BT) + col * 128 + (((4 * ks + kb) ^ (col & 7)) << 4)), fr_ = *(const LAS bf16x8*)(IMG + IMG_RT + col * 128 + (((4 * ks + kb) ^ (col & 7)) << 4));
                    d4 = __builtin_amdgcn_mfma_f32_16x16x32_bf16(fa, fr_, d4, 0, 0, 0); }
#pragma unroll
                for (int c = 0; c < 4; ++c) if (!(4 * kb + c <= col)) d4[c] = 0.f;
                *(LAS u32x2*)(ABRp + (kb * 16 + col) * 16 + which * 8) = (u32x2){pk2(d4[0], d4[1]), pk2(d4[2], d4[3])};
                }
            }
        }
        }
        LDS_WAIT(); __builtin_amdgcn_s_barrier(); asm volatile("" ::: "memory");
        if (wave >= 4) {
            if (act) {
                u32x2 at2[2], rt2[2], bt2[2], kt2[2], bh2[2], kh2[2]; float rho2[2];
#pragma unroll
                for (int hr = 0; hr < 2; ++hr) { const int srow = srow0 + 16 * hr;
        {
            const int sc = srow >> 4, t = srow & 15; const int o = (srow * 64 + 4 * cq) * 4;
            gA[hr] = *(const LAS f32x4*)(L + O_G + o);
            const f32x4 av = *(const LAS f32x4*)(L + O_B + o), cl4 = *(const LAS f32x4*)(L + O_CL + o);
            f32x4 cp4 = *(const LAS f32x4*)(L + O_CL + (((t > 0 ? srow - 1 : srow)) * 64 + 4 * cq) * 4); if (t == 0) cp4 = (f32x4){0.f, 0.f, 0.f, 0.f};
            const f32x4 ka_w = *(const LAS f32x4*)(L + O_CT + (10 * 64 + 4 * cqv) * 4), rk_w = *(const LAS f32x4*)(L + O_CT + (11 * 64 + 4 * cqv) * 4);
            const f32x4 wc4 = *(const LAS f32x4*)(L + O_WC + (ci & 1) * 512 + (sc * 64 + 4 * cq) * 4);
            float rho = 0.f; f32x4 at, rt, bt, kt, bh, kh;
#pragma unroll
            for (int c = 0; c < 4; ++c) { const float kd = ksA[hr][c] * (1.f + (av[c] - 1.f) * ka_w[c]), bb = kkA[hr][c] * av[c]; rho += rsA[hr][c] * kd * rk_w[c];
                const float ec = __expf(cl4[c]), em = frcp(ec), ep = __expf(cp4[c]), eC = wc4[c] * em;
                at[c] = -kkA[hr][c] * ep; rt[c] = rsA[hr][c] * ec; bt[c] = bb * em; kt[c] = kd * em; bh[c] = bb * eC; kh[c] = kd * eC; }
            at2[hr] = PK4(at); rt2[hr] = PK4(rt); bt2[hr] = PK4(bt); kt2[hr] = PK4(kt); bh2[hr] = PK4(bh); kh2[hr] = PK4(kh);
            rho2[hr] = red16(rho);
        }
                }
#pragma unroll
                for (int hr = 0; hr < 2; ++hr) { const int srow = srow0 + 16 * hr;
        {
            const int sc = srow >> 4, t = srow & 15; const int swo = t * 128 + (((cq >> 1) ^ (t & 7)) << 4) + ((cq & 1) << 3);
            if (cq == 0) *(LAS float*)(L + O_RHO + (ci & 1) * 256 + srow * 4) = rho2[hr];
            LAS unsigned char* IMG = L + stg + sc * IMG_SC; LAS unsigned char* KHp = IMX_KHP(ci & 1, sc); LAS unsigned char* VRp = IMX_VRP(ci & 1, sc);
            *(LAS u32x2*)(IMG + IMG_AT + swo) = at2[hr]; *(LAS u32x2*)(IMG + IMG_RT + swo) = rt2[hr];
            *(LAS u32x2*)(IMG + IMG_BT + swo) = bt2[hr]; *(LAS u32x2*)(IMG + IMG_KT + swo) = kt2[hr];
            const int jt = cq >> 2, kb = cq & 3;
            *(LAS u32x2*)(IMG + IMG_RTP + (((jt >> 1) * 4 + kb) * 16 + t) * 16 + (jt & 1) * 8) = rt2[hr];
            *(LAS u32x2*)(IMG + IMG_BH + swo) = bh2[hr]; *(LAS u32x2*)(KHp + swo) = kh2[hr]; *(LAS u32x2*)(VRp + swo) = PK4(vsA[hr]);
        }
                }
            }
        } else if (ci >= 1)
        {
            int lane = F.lane; asm volatile("" : "+v"(lane));
            const int kb = lane >> 4, ig = 16 * wave + (lane & 15);
            bf16x8 fq_[2][2], fr_[2][2], fab0_[2], fabr_[2]; u32x2 bl_[2][4], kl_[2][4], vt_[2]; f32x4 wcv_[2][4];
#pragma unroll
            for (int sc = 0; sc < 2; ++sc) {
                const LAS unsigned char* IMG = L + stgp + sc * IMG_SC;
                vt_[sc] = trd(IMX_VRP(pp, sc), 16 * wave, lane);
#pragma unroll
                for (int ks = 0; ks < 2; ++ks) { fq_[sc][ks] = *(const LAS bf16x8*)(IMG + IMG_QT + (ks * 64 + lane) * 16); fr_[sc][ks] = *(const LAS bf16x8*)(IMG + IMG_RTP + (ks * 64 + lane) * 16); }
                fab0_[sc] = *(const LAS bf16x8*)(IMX_AB0P(pp, sc) + lane * 16); fabr_[sc] = *(const LAS bf16x8*)(IMX_ABRP(pp, sc) + lane * 16);
#pragma unroll
                for (int jt = 0; jt < 4; ++jt) { if (sc == 0) wcv_[0][jt] = *(const LAS f32x4*)(L + O_WC + pp * 512 + (16 * jt + 4 * kb) * 4); bl_[sc][jt] = trd(IMG + IMG_BH, 16 * jt, lane); kl_[sc][jt] = trd(IMX_KHP(pp, sc), 16 * jt, lane); }
            }
#pragma unroll
            for (int sc = 0; sc < 2; ++sc) {
                bf16x8 S0f[2];
                if (sc == 1) {
#pragma unroll
                    for (int jt = 0; jt < 4; ++jt) wcv_[1][jt] = *(const LAS f32x4*)(L + O_WC + pp * 512 + 256 + (16 * jt + 4 * kb) * 4); }
#pragma unroll
                for (int ks = 0; ks < 2; ++ks) S0f[ks] = __builtin_bit_cast(bf16x8, (u32x4){pk2(Sreg[2 * ks][0], Sreg[2 * ks][1]), pk2(Sreg[2 * ks][2], Sreg[2 * ks][3]), pk2(Sreg[2 * ks + 1][0], Sreg[2 * ks + 1][1]), pk2(Sreg[2 * ks + 1][2], Sreg[2 * ks + 1][3])});
                const u32x2 vt = vt_[sc];
                f32x4 sa = {0.f, 0.f, 0.f, 0.f}, y = sa;
#pragma unroll
                for (int ks = 0; ks < 2; ++ks) { sa = __builtin_amdgcn_mfma_f32_16x16x32_bf16(fq_[sc][ks], S0f[ks], sa, 0, 0, 0);
                                                 y = __builtin_amdgcn_mfma_f32_16x16x32_bf16(fr_[sc][ks], S0f[ks], y, 0, 0, 0); }
                sa = __builtin_amdgcn_mfma_f32_16x16x32_bf16(fab0_[sc], __builtin_bit_cast(bf16x8, (u32x4){0u, 0u, vt.x, vt.y}), sa, 0, 0, 0);
                const bf16x8 Bsv = __builtin_bit_cast(bf16x8, (u32x4){pk2(sa[0], sa[1]), pk2(sa[2], sa[3]), vt.x, vt.y});
                y = __builtin_amdgcn_mfma_f32_16x16x32_bf16(fabr_[sc], Bsv, y, 0, 0, 0);
#pragma unroll
                for (int c = 0; c < 4; ++c) *(LAS float*)(L + O_Y + ((16 * sc + 4 * kb + c) * 64 + ig) * 4) = y[c];
#pragma unroll
                for (int jt = 0; jt < 4; ++jt)
                    Sreg[jt] = __builtin_amdgcn_mfma_f32_16x16x32_bf16(__builtin_bit_cast(bf16x8, (u32x4){bl_[sc][jt].x, bl_[sc][jt].y, kl_[sc][jt].x, kl_[sc][jt].y}), Bsv, Sreg[jt] * wcv_[sc][jt], 0, 0, 0);
            }
        }

        if (wave < 4) asm volatile("s_waitcnt vmcnt(0)" ::: "memory");
        LDS_WAIT(); __builtin_amdgcn_s_barrier(); asm volatile("" ::: "memory");
#pragma unroll
        for (int hr = 0; hr < 2; ++hr) { g_p2[hr] = g_p1[hr]; g_p1[hr] = gA[hr]; }
        sbuf = sbuf == 2 ? 0 : sbuf + 1;
    }
    if (wave >= 4) {
#pragma unroll
        for (int hr = 0; hr < 2; ++hr) { const int srow = srow0 + 16 * hr; const f32x4 vsb = VS_BACK(NCH - 1, hr); READOUT(NCH - 1, vsb, g_p2[hr]); } }
    WAIT_BAR_ALL();
#undef VS_BACK
#undef IMX_KHP
#undef IMX_VRP
#undef IMX_AB0P
#undef IMX_ABRP
#undef READOUT
#undef LORA_TILE
#undef LORA_LOAD
#undef CHUNK_GEOM
#undef PK4
}
}

namespace att {
constexpr int KVB = 64, NTILE = (CT + T) / KVB;
constexpr int KSLOT = 5120, VSLOT = 10240, VPITCH = 80, KPITCH = 80;
constexpr int NSLOT = 5;
constexpr int L_K = 0, L_V = NSLOT * KSLOT, L_WS = L_V + NSLOT * VSLOT, L_ST = L_WS + NWAVES * 256, L_END = L_ST + NWAVES * 8192;
static_assert(L_END <= MISC_OFF, "attention LDS");
typedef __attribute__((address_space(3))) const char* lds_cptr;
typedef short v4i16_t __attribute__((ext_vector_type(4)));
__device__ __forceinline__ int crow(int r, int hi) { return (r & 3) + 8 * (r >> 2) + 4 * hi; }
__device__ __forceinline__ s16x4 vtr(lds_cptr p) { return __builtin_bit_cast(s16x4, __builtin_amdgcn_ds_read_tr16_b64_v4i16((__attribute__((address_space(3))) v4i16_t*)p)); }
__device__ __forceinline__ unsigned cvtpk(float lo, float hi) { typedef float f2 __attribute__((ext_vector_type(2))); typedef __bf16 b2 __attribute__((ext_vector_type(2)));
    f2 v = {lo, hi}; b2 b = __builtin_convertvector(v, b2); return __builtin_bit_cast(unsigned, b); }

__device__ __forceinline__ int krow(int b, int key) { return key < CT ? M + b * CT + key : b * T + (key - CT); }

__device__ __forceinline__ float max3f(float a, float b, float c) { float r; asm("v_max3_f32 %0, %1, %2, %3" : "=v"(r) : "v"(a), "v"(b), "v"(c)); return r; }
__device__ __forceinline__ void glds16_sv(const unsigned char* sbase, unsigned voff, unsigned lds_dst) { unsigned keep;
    asm volatile("s_mov_b32 %0, m0\n\ts_mov_b32 m0, %3\n\ts_nop 0\n\tglobal_load_lds_dwordx4 %1, %2\n\ts_mov_b32 m0, %0" : "=&s"(keep) : "v"(voff), "s"(sbase), "s"(lds_dst) : "memory"); }
__device__ __forceinline__ void issue_k(Frame& F, const bf16*  , int b, int h, int m, int t, int slot, unsigned lds0) {
    if (F.wave < 5) { const unsigned char* sb = F.ws + WS_K8 + (size_t)(((b * 4 + h) * 2 + m) * NTILE + t) * KSLOT;
        glds16_sv(sb, (unsigned)(F.wave * 1024 + F.lane * 16), (unsigned)__builtin_amdgcn_readfirstlane(lds0 + L_K + slot * KSLOT + F.wave * 1024)); } }
__device__ __forceinline__ void issue_v(Frame& F, const bf16*  , int b, int h, int t, int slot, unsigned lds0) {
    const unsigned char* sb = F.ws + WS_VT8 + (size_t)((b * 4 + h) * NTILE + t) * VSLOT; const unsigned vo = (unsigned)(F.wave * 1024 + F.lane * 16);
    glds16_sv(sb, vo, (unsigned)__builtin_amdgcn_readfirstlane(lds0 + L_V + slot * VSLOT + F.wave * 1024));
    if (F.wave < 2) glds16_sv(sb + 8192, vo, (unsigned)__builtin_amdgcn_readfirstlane(lds0 + L_V + slot * VSLOT + 8192 + F.wave * 1024));
}

__device__ __forceinline__ void prime(Frame& F, int b, int h, int m) {
    const bf16* PKD = (const bf16*)(F.ws + WS_PX + 5 * U); const bf16* PVD = (const bf16*)(F.ws + WS_PX + 6 * U); const unsigned lds0 = (unsigned)(uintptr_t)F.lds;
    issue_k(F, PKD, b, h, m, 0, 0, lds0); issue_v(F, PVD, b, h, 0, 0, lds0); issue_k(F, PKD, b, h, m, 1, 1, lds0); issue_v(F, PVD, b, h, 1, 1, lds0); issue_k(F, PKD, b, h, m, 2, 2, lds0); issue_v(F, PVD, b, h, 2, 2, lds0); issue_k(F, PKD, b, h, m, 3, 3, lds0);
}
__device__ __forceinline__ void unit(Frame& F, int b, int h, int qb, float lam, bool primed, bool has_next, int nb, int nh) {
    const int lane = F.lane, wid = F.wave, r32 = lane & 31, hi = lane >> 5;
    LAS unsigned char* L = F.lds; const unsigned lds0 = (unsigned)(uintptr_t)L;
    const bf16* PQ = (const bf16*)(F.ws + WS_PX + 4 * U); const bf16* PKD = (const bf16*)(F.ws + WS_PX + 5 * U); const bf16* PVD = (const bf16*)(F.ws + WS_PX + 6 * U);
    bf16* OC = (bf16*)(F.ws + WS_OCAT);
    LAS float* wsf = (LAS float*)(L + L_WS) + wid * 64;
    LAS bf16* stash = (LAS bf16*)(L + L_ST + wid * 8192);
    const int qrow0 = b * T + qb * 256 + wid * 32;
    const lds_cptr kbase = (lds_cptr)L + L_K + r32 * KPITCH + hi * 32;
    const lds_cptr vbase = (lds_cptr)L + L_V + r32 * VPITCH + hi * 32;
    f32x16 o[4];
#pragma unroll 1
    for (int m = 0; m < 2; ++m) {
        if (m == 0 && !primed) prime(F, b, h, 0);
        pg8::i32x8_t q8;
#pragma unroll
        for (int i = 0; i < 4; ++i) { int lq_ = lane; asm volatile("" : "+v"(lq_));
            const u32x4 u = *(const u32x4*)(PQ + (size_t)(qrow0 + (lq_ & 31)) * 512 + h * 128 + m * 64 + 32 * (lq_ >> 5) + 8 * i);
            q8[2 * i] = (int)pk4f8(8.f * bflo(u.x), 8.f * bfhi(u.x), 8.f * bflo(u.y), 8.f * bfhi(u.y)); q8[2 * i + 1] = (int)pk4f8(8.f * bflo(u.z), 8.f * bfhi(u.z), 8.f * bflo(u.w), 8.f * bfhi(u.w)); }
#pragma unroll
        for (int d = 0; d < 4; ++d)
#pragma unroll
            for (int r = 0; r < 16; ++r) o[d][r] = 0.f;
        float mrun = 0.f;
        f32x16 lacc;
#pragma unroll
        for (int r = 0; r < 16; ++r) lacc[r] = 0.f;
        const pg8::i32x8_t ones8 = {0x38383838, 0x38383838, 0x38383838, 0x38383838, 0x38383838, 0x38383838, 0x38383838, 0x38383838};
        WAIT_BAR_ALL();
#define QKT_LOAD(kA_, kB_, ks_) do { const lds_cptr kp_ = kbase + (ks_) * KSLOT; \
            const pg8::i32x4_t ka_ = *(const __attribute__((address_space(3))) pg8::i32x4_t*)(kp_), kb_ = *(const __attribute__((address_space(3))) pg8::i32x4_t*)(kp_ + 16), \
                               kc_ = *(const __attribute__((address_space(3))) pg8::i32x4_t*)(kp_ + 32 * KPITCH), kd_ = *(const __attribute__((address_space(3))) pg8::i32x4_t*)(kp_ + 32 * KPITCH + 16); \
            kA_ = __builtin_shufflevector(ka_, kb_, 0, 1, 2, 3, 4, 5, 6, 7); kB_ = __builtin_shufflevector(kc_, kd_, 0, 1, 2, 3, 4, 5, 6, 7); } while (0)
#define QKT_MMA(P0, P1, kA_, kB_, C_) do { \
            P0 = __builtin_amdgcn_mfma_scale_f32_32x32x64_f8f6f4(kA_, q8, C_, 0, 0, 0, 0x7F7F7F7F, 0, 0x7F7F7F7F); \
            P1 = __builtin_amdgcn_mfma_scale_f32_32x32x64_f8f6f4(kB_, q8, C_, 0, 0, 0, 0x7F7F7F7F, 0, 0x7F7F7F7F); \
            asm volatile("" : "+v"(P0), "+v"(P1) : "v"(kA_), "v"(kB_));              \
            } while (0)
#define QKT(P0, P1, ks_, C_) do { pg8::i32x8_t kA__, kB__; QKT_LOAD(kA__, kB__, ks_); QKT_MMA(P0, P1, kA__, kB__, C_); } while (0)
#define ROWMAX(P0, P1, rm_) do { float a_ = max3f(P0[0], P0[1], P1[0]), b_ = max3f(P0[2], P0[3], P1[1]); a_ = max3f(a_, P1[2], P1[3]); \
            _Pragma("unroll") for (int r = 4; r < 16; r += 4) { a_ = max3f(a_, P0[r], P0[r + 1]); b_ = max3f(b_, P0[r + 2], P0[r + 3]); a_ = max3f(a_, P1[r], P1[r + 1]); b_ = max3f(b_, P1[r + 2], P1[r + 3]); } \
            rm_ = max3f(a_, b_, b_); { auto rr_ = __builtin_amdgcn_permlane32_swap(__float_as_uint(rm_), __float_as_uint(rm_), false, false); rm_ = max3f(__uint_as_float(rr_[0]), __uint_as_float(rr_[1]), __uint_as_float(rr_[1])); } } while (0)
        pg8::i32x8_t paA, paB;
        f32x16 pA0, pA1;
        const f32x16 z16 = {0.f, 0.f, 0.f, 0.f, 0.f, 0.f, 0.f, 0.f, 0.f, 0.f, 0.f, 0.f, 0.f, 0.f, 0.f, 0.f};
        QKT(pA0, pA1, 0, z16);
        asm volatile("s_nop 15\n\ts_nop 15\n\ts_nop 15\n\ts_nop 15\n\ts_nop 15\n\ts_nop 15\n\ts_nop 15\n\ts_nop 15\n\ts_nop 15\n\ts_nop 15" : "+v"(pA0), "+v"(pA1));
        f32x16 negm;
        { float rm; ROWMAX(pA0, pA1, rm); mrun = rm - 24.f;
#pragma unroll
          for (int r = 0; r < 16; ++r) { negm[r] = 56.5f - mrun; pA0[r] += negm[r]; pA1[r] += negm[r]; } }
#define PACKU8(dst_, X_, base_) do { _Pragma("unroll") for (int q = 0; q < 4; ++q) { unsigned w_ = 0u; _Pragma("unroll") for (int e = 0; e < 4; ++e) w_ = __builtin_amdgcn_cvt_pk_u8_f32(X_[4 * q + e], e, w_); dst_[(base_) + q] = (int)w_; } } while (0)
        PACKU8(paA, pA0, 0); PACKU8(paA, pA1, 4);
#define STEP(PAc, PAn, t_, MORE_, BAR_) do { const int tt_ = (t_); f32x16 N0, N1; \
              \
            if (BAR_) { \
            if (tt_ < NTILE - 3) { if (wid < 2) asm volatile("s_waitcnt vmcnt(3) lgkmcnt(0)\n\ts_barrier" ::: "memory"); else if (wid < 5) asm volatile("s_waitcnt vmcnt(2) lgkmcnt(0)\n\ts_barrier" ::: "memory"); \
                                   else asm volatile("s_waitcnt vmcnt(1) lgkmcnt(0)\n\ts_barrier" ::: "memory"); } \
            else asm volatile("s_waitcnt vmcnt(0) lgkmcnt(0)\n\ts_barrier" ::: "memory");        \
            } \
            const int s0_ = tt_ % 5  , s1_ = (tt_ + 1) % 5  , kw_ = (tt_ + 4) % 5  , vw_ = (tt_ + 3) % 5  ; \
            constexpr bool more_ = (MORE_); \
            pg8::i32x8_t kfA_, kfB_; if (more_) QKT_LOAD(kfA_, kfB_, s1_);        \
            if (tt_ + 4 < NTILE) issue_k(F, PKD, b, h, m, tt_ + 4, kw_, lds0); \
            if (tt_ + 3 < NTILE) issue_v(F, PVD, b, h, tt_ + 3, vw_, lds0); \
              \
            if (more_) QKT_MMA(N0, N1, kfA_, kfB_, negm); \
            const pg8::i32x8_t pa8_ = PAc;                         \
            const lds_cptr vp_ = vbase + s0_ * VSLOT; \
            float f_ = 1.f; bool resc_ = false; \
            pg8::i32x4_t vlo_[2], vhi_[2];                         \
            _Pragma("unroll") for (int gp = 0; gp < 2; ++gp) { vlo_[gp] = *(const __attribute__((address_space(3))) pg8::i32x4_t*)(vp_ + gp * 32 * VPITCH); vhi_[gp] = *(const __attribute__((address_space(3))) pg8::i32x4_t*)(vp_ + gp * 32 * VPITCH + 16); } \
            __builtin_amdgcn_sched_barrier(0); \
              \
            _Pragma("unroll") for (int g = 0; g < 4; ++g) { \
                const pg8::i32x8_t vb_ = __builtin_shufflevector(vlo_[g & 1], vhi_[g & 1], 0, 1, 2, 3, 4, 5, 6, 7); \
                o[g] = __builtin_amdgcn_mfma_scale_f32_32x32x64_f8f6f4(pa8_, vb_, o[g], 0, 0, 0, 0x7F7F7F7F, 0, 0x7F7F7F7F); \
                if (g == 3) lacc = __builtin_amdgcn_mfma_scale_f32_32x32x64_f8f6f4(pa8_, ones8, lacc, 0, 0, 0, 0x7F7F7F7F, 0, 0x7F7F7F7F); \
                if (g < 2) { vlo_[g & 1] = *(const __attribute__((address_space(3))) pg8::i32x4_t*)(vp_ + (g + 2) * 32 * VPITCH); vhi_[g & 1] = *(const __attribute__((address_space(3))) pg8::i32x4_t*)(vp_ + (g + 2) * 32 * VPITCH + 16); } \
                if (more_) { \
                    if (g == 1) { asm volatile("" : "+v"(N0), "+v"(N1) : "v"(o[0]), "v"(o[1]));        \
                        float rm_; ROWMAX(N0, N1, rm_);                       \
                        if (__any(rm_ > 120.5f)) { const float dl_ = fmaxf(rm_ - 80.5f, 0.f); f_ = __builtin_amdgcn_exp2f(-0.125f * dl_); resc_ = true; \
                            _Pragma("unroll") for (int r = 0; r < 16; ++r) { N0[r] -= dl_; N1[r] -= dl_; negm[r] -= dl_; } } } \
                    if (g == 2) { PACKU8(PAn, N0, 0); asm volatile("" : "+v"(PAn)); } \
                    if (g == 3) { PACKU8(PAn, N1, 4); asm volatile("" : "+v"(PAn)); } } \
                __builtin_amdgcn_sched_barrier(0); } \
            if (resc_) { asm volatile("s_nop 15\n\ts_nop 15\n\ts_nop 15\n\ts_nop 15\n\ts_nop 15\n\ts_nop 15\n\ts_nop 15\n\ts_nop 15" ::: "memory");     \
                if (hi == 0) wsf[r32] = f_; \
                LDS_WAIT(); asm volatile("" ::: "memory"); \
                _Pragma("unroll") for (int r = 0; r < 16; ++r) { const float fr_ = wsf[crow(r, hi)]; lacc[r] *= fr_; \
                    _Pragma("unroll") for (int d = 0; d < 4; ++d) o[d][r] *= fr_; } \
                LDS_WAIT(); asm volatile("" ::: "memory"); } \
        } while (0)
#pragma unroll 1
        for (int t = 0; t < NTILE - 2; t += 2) { STEP(paA, paB, t, true, true); STEP(paB, paA, t + 1, true, false); }
        STEP(paA, paB, NTILE - 2, true, true); STEP(paB, paA, NTILE - 1, false, false);
#undef STEP
#undef PACKU8
#undef QKT
#undef QKT_LOAD
#undef QKT_MMA
#undef ROWMAX
        WAIT_BAR_ALL();
        if (m == 0) prime(F, b, h, 1); else if (has_next) prime(F, nb, nh, 0);
        int lane_e = lane; asm volatile("" : "+v"(lane_e)); const int r32e = lane_e & 31, hie = lane_e >> 5;
        LAS bf16* stash_e = (LAS bf16*)(L + L_ST + wid * 8192); LAS float* wsf_e = (LAS float*)(L + L_WS) + wid * 64;
        float rl[16];
#pragma unroll
        for (int r = 0; r < 16; ++r) rl[r] = frcp(lacc[r]);
        (void)wsf_e;
        if (m == 0) {
#pragma unroll
            for (int r = 0; r < 16; ++r)
#pragma unroll
                for (int d = 0; d < 4; ++d) stash_e[crow(r, hie) * 128 + d * 32 + r32e] = (bf16)f2bf(o[d][r] * rl[r]);
            LDS_WAIT(); asm volatile("" ::: "memory");
        } else {
            const float* sub = F.in[I_SUBLN];
            float sw4[4];
#pragma unroll
            for (int d = 0; d < 4; ++d) sw4[d] = sub[d * 32 + r32e] * 0.8f;
            unsigned short o0h[16][4];
#pragma unroll
            for (int r = 0; r < 16; ++r)
#pragma unroll
                for (int d = 0; d < 4; ++d) o0h[r][d] = stash_e[crow(r, hie) * 128 + d * 32 + r32e];
            float ssv[16];
#pragma unroll
            for (int r = 0; r < 16; ++r) { float ss = 0.f;
#pragma unroll
                for (int d = 0; d < 4; ++d) { const float o0 = bflo((unsigned)o0h[r][d]); const float a = o0 - lam * (o[d][r] * rl[r]); o[d][r] = a; ss += a * a; }
                ssv[r] = red16(ss); }
#pragma unroll
            for (int r = 0; r < 16; ++r) ssv[r] += __builtin_bit_cast(float, __builtin_amdgcn_ds_swizzle(__builtin_bit_cast(int, ssv[r]), 0x401F));
#pragma unroll
            for (int r = 0; r < 16; ++r) { const float rinv = frsq(ssv[r] * (1.f / 128.f) + NORM_EPS);
#pragma unroll
                for (int d = 0; d < 4; ++d) o[d][r] = o[d][r] * rinv * sw4[d]; }
            LDS_WAIT(); asm volatile("" ::: "memory");
#pragma unroll
            for (int r = 0; r < 16; ++r)
#pragma unroll
                for (int d = 0; d < 4; ++d) stash_e[crow(r, hie) * 128 + d * 32 + r32e] = (bf16)f2bf(o[d][r]);
            LDS_WAIT(); asm volatile("" ::: "memory");
#pragma unroll
            for (int i = 0; i < 8; ++i) { const int row = i * 4 + (lane_e >> 4), chk = lane_e & 15;
                const u32x4 v = *(const LAS u32x4*)(stash_e + row * 128 + chk * 8);
                *(u32x2*)((unsigned char*)OC + (size_t)(qrow0 + row) * 1536 + 1024 + h * 128 + chk * 8) = (u32x2){pk4f8(bflo(v.x), bfhi(v.x), bflo(v.y), bfhi(v.y)), pk4f8(bflo(v.z), bfhi(v.z), bflo(v.w), bfhi(v.w))}; }
            LDS_WAIT(); asm volatile("" ::: "memory");
        }
    }
    WAIT_BAR_ALL();
}
}

__device__ __forceinline__ void phase_vt8(Frame& F) {
    const bf16* PVD = (const bf16*)(F.ws + WS_PX + 6 * U); unsigned char* VT = F.ws + WS_VT8;
    LAS unsigned char* Tl = F.lds + 16384 + F.wave * att::VSLOT;
    const int gw = F.vcu * NWAVES + F.wave, NGW = F.G * NWAVES, lane = F.lane;
    const int chunk = lane & 15, rq = lane >> 4;
    for (int it = gw; it < NB * 4 * att::NTILE; it += NGW) {
        const int b = it / (4 * att::NTILE), h = (it / att::NTILE) & 3, t = it % att::NTILE;
        u32x4 raw[16];
#pragma unroll
        for (int i = 0; i < 16; ++i) raw[i] = *(const u32x4*)(PVD + (size_t)att::krow(b, t * 64 + 4 * i + rq) * 512 + h * 128 + 8 * chunk);
#pragma unroll
        for (int i = 0; i < 16; ++i) {
            const int pos = (i & 1) * 32 + 16 * (i >> 3) + 4 * ((i & 7) >> 1) + rq;
            const u32x4 u = raw[i];
            const unsigned w0 = (unsigned)__builtin_amdgcn_cvt_pk_fp8_f32(bflo(u.x), bfhi(u.x), 0, false), w1 = (unsigned)__builtin_amdgcn_cvt_pk_fp8_f32(bflo(u.y), bfhi(u.y), 0, false),
                           w2 = (unsigned)__builtin_amdgcn_cvt_pk_fp8_f32(bflo(u.z), bfhi(u.z), 0, false), w3 = (unsigned)__builtin_amdgcn_cvt_pk_fp8_f32(bflo(u.w), bfhi(u.w), 0, false);
            LAS unsigned char* p = Tl + (8 * chunk) * att::VPITCH + pos;
            p[0 * att::VPITCH] = (unsigned char)(w0 & 255u); p[1 * att::VPITCH] = (unsigned char)((w0 >> 8) & 255u); p[2 * att::VPITCH] = (unsigned char)(w1 & 255u); p[3 * att::VPITCH] = (unsigned char)((w1 >> 8) & 255u);
            p[4 * att::VPITCH] = (unsigned char)(w2 & 255u); p[5 * att::VPITCH] = (unsigned char)((w2 >> 8) & 255u); p[6 * att::VPITCH] = (unsigned char)(w3 & 255u); p[7 * att::VPITCH] = (unsigned char)((w3 >> 8) & 255u);
        }
        LDS_WAIT(); asm volatile("" ::: "memory");
#pragma unroll
        for (int j = 0; j < 10; ++j) *(u32x4*)(VT + (size_t)it * att::VSLOT + (lane + 64 * j) * 16) = *(const LAS u32x4*)(Tl + (lane + 64 * j) * 16);
        LDS_WAIT(); asm volatile("" ::: "memory");
    }
}

#define X1ROW(out_, row_) ((const unsigned char*)(out_) + (size_t)(row_) * 4096 + 2048)
struct EpiWout {
    static constexpr bool PERM = true, AFTER_DRAIN = false;
    const float* x; float* out; const float* mod;
    __device__ __forceinline__ void operator()(const pg8::f32x4 (&acc)[2][2][4][2], const pg8::Unit& u, int wr, int wc, int fr, int fq) const {
        const int col0 = u.pn * 256 + wc * 32 + 8 * fq; const int b = (u.pm * 256) >> 12;
        f32x4 gv[2][2];
#pragma unroll
        for (int bj = 0; bj < 2; ++bj)
#pragma unroll
            for (int n = 0; n < 2; ++n) gv[bj][n] = *(const f32x4*)(mod + b * 6144 + 2048 + col0 + bj * 128 + n * 4) * (1.f / WO_SCALE);
#pragma unroll
        for (int ai = 0; ai < 2; ++ai)
#pragma unroll
            for (int mp = 0; mp < 2; ++mp) { f32x4 xv[2][2][2];
#pragma unroll
                for (int mm = 0; mm < 2; ++mm) { const size_t off = (size_t)(u.pm * 256 + ai * 128 + wr * 64 + (2 * mp + mm) * 16 + fr) * D + col0;
#pragma unroll
                    for (int bj = 0; bj < 2; ++bj)
#pragma unroll
                        for (int n = 0; n < 2; ++n) xv[mm][bj][n] = *(const f32x4*)(x + off + bj * 128 + n * 4); }
#pragma unroll
                for (int mm = 0; mm < 2; ++mm) { const int m = 2 * mp + mm; const size_t row = (size_t)(u.pm * 256 + ai * 128 + wr * 64 + m * 16 + fr);
#pragma unroll
                    for (int bj = 0; bj < 2; ++bj) { const f32x4 v0 = xv[mm][bj][0] + gv[bj][0] * acc[ai][bj][m][0], v1 = xv[mm][bj][1] + gv[bj][1] * acc[ai][bj][m][1];
                        *(u32x4*)((unsigned char*)out + row * 4096 + 2048 + (col0 + bj * 128) * 2) = (u32x4){pk2(v0[0], v0[1]), pk2(v0[2], v0[3]), pk2(v1[0], v1[1]), pk2(v1[2], v1[3])}; } } }
    }
};
struct EpiSwiGLU {
    static constexpr bool PERM = true, AFTER_DRAIN = false;
    bf16* hid;
    __device__ __forceinline__ void operator()(const pg8::f32x4 (&acc)[2][2][4][2], const pg8::Unit& u, int wr, int wc, int fr, int fq) const {
        const int ct = u.pn & 3; const int col0 = ct * 128 + wc * 32 + 8 * fq;
#pragma unroll
        for (int ai = 0; ai < 2; ++ai)
#pragma unroll
            for (int m = 0; m < 4; ++m) { const size_t row = (size_t)u.pm * 256 + ai * 128 + wr * 64 + m * 16 + fr;
                float hv[8];
#pragma unroll
                for (int n = 0; n < 2; ++n)
#pragma unroll
                    for (int j = 0; j < 4; ++j) { const float g = acc[ai][0][m][n][j] * (1.f / W1_SCALE), uu = acc[ai][1][m][n][j] * (1.f / W1_SCALE); const float hh = g * frcp(1.f + __expf(-g)) * uu;
                        hv[4 * n + j] = __builtin_amdgcn_fmed3f(hh, -448.f, 448.f); }
                *(u32x2*)((unsigned char*)hid + row * 512 + col0) = (u32x2){pk4f8(hv[0], hv[1], hv[2], hv[3]), pk4f8(hv[4], hv[5], hv[6], hv[7])}; }
    }
};
struct EpiYS {
    static constexpr bool PERM = true, AFTER_DRAIN = false;
    bf16* ys; const float* sw;
    __device__ __forceinline__ void operator()(const pg8::f32x4 (&acc)[2][2][4][2], const pg8::Unit& u, int wr, int wc, int fr, int fq) const {
        const int col0 = (u.pn & 3) * 256 + wc * 32 + 8 * fq;
#pragma unroll
        for (int ai = 0; ai < 2; ++ai)
#pragma unroll
            for (int m = 0; m < 4; ++m) { const size_t srow = (size_t)u.pm * 256 + ai * 128 + wr * 64 + m * 16 + fr;
#pragma unroll
                for (int bj = 0; bj < 2; ++bj) { f32x4 v0 = acc[ai][bj][m][0], v1 = acc[ai][bj][m][1];
#pragma unroll
                    for (int c = 0; c < 4; ++c) { v0[c] = __builtin_amdgcn_fmed3f(v0[c], -448.f, 448.f); v1[c] = __builtin_amdgcn_fmed3f(v1[c], -448.f, 448.f); }
                    *(u32x2*)((unsigned char*)ys + srow * 1024 + col0 + bj * 128) = (u32x2){pk4f8(v0[0], v0[1], v0[2], v0[3]), pk4f8(v1[0], v1[1], v1[2], v1[3])}; } }
    }
};
struct GroupedOrder {
    const LAS int* tstart;
    int rt_lo, nunits, G, c;
    __device__ __forceinline__ bool next(int i, pg8::Unit& u) const {
        const int Lx = i * G + c; if (Lx >= nunits) return false;
        const int rt = rt_lo + (Lx >> 2), ct = Lx & 3; int g = 0;
        for (int k = 32; k >= 1; k >>= 1) if (tstart[g + k] <= rt) g += k;
        while (tstart[g + 1] <= rt) ++g;
        u.pm = rt; u.pn = (g & 31) * 4 + ct; u.aux = g; return true;
    }
    __device__ __forceinline__ void a_ready(const pg8::Unit&) const {}
    __device__ __forceinline__ void done(const pg8::Unit&) const {}
    const int* stokg = nullptr;
    __device__ __forceinline__ int map_row(const pg8::Unit& u, int R) const { const int g = u.aux; const int pos = (u.pm - tstart[g]) * 256 + R; const bool in = pos < tstart[65 + g];
        const int tok = stokg[(size_t)g * GCAP + (in ? pos : 0)]; return in ? tok : M; }
};
constexpr int TS_OFF = 131072;
__device__ __forceinline__ void build_tstart(Frame& F) {
    LAS int* ts = (LAS int*)(F.lds + TS_OFF); const int* cnt = (const int*)(F.ws + WS_CTL);
    if (F.tid == 0) { int acc = 0; for (int g = 0; g < 64; ++g) { const int c = cnt[g * CNT_STRIDE]; ts[g] = acc; ts[65 + g] = c; acc += (c + 255) >> 8; } ts[64] = acc; }
    __syncthreads();
}

__device__ __forceinline__ void phase_router_generic(Frame& F) {
    LAS float* WL = (LAS float*)F.lds;
    LAS float* BL = (LAS float*)(F.lds + 36 * 1024 * 4);
    const float* WR = (const float*)(F.ws + WS_ROUT);
    for (int i = F.tid; i < 36 * 256; i += NTHR) ((LAS f32x4*)WL)[i] = ((const f32x4*)WR)[i];
    if (F.tid < 36) BL[F.tid] = F.tid < 4 ? F.in[I_BG][F.tid] : F.in[I_BE][F.tid - 4];
    __syncthreads();
    const int gw = F.vcu * NWAVES + F.wave, NGW = F.G * NWAVES, lane = F.lane;
    const float* mod = (const float*)(F.ws + WS_MOD); const float* nw = F.in[I_N2W];
    bf16* H2 = (bf16*)(F.ws + WS_H2); int* TI = (int*)(F.ws + WS_TI); float* TW = (float*)(F.ws + WS_TW); int* cnt = (int*)(F.ws + WS_CTL);
    if (gw == 0) { u32x4* z = (u32x4*)((unsigned char*)H2 + (size_t)M * D) + lane; z[0] = (u32x4){0u, 0u, 0u, 0u}; }
    int my_e = 0, my_row = -1; float my_w0 = 0.f, my_w1 = 0.f; int nparked = 0;
#define ROUTER_FLUSH() do { if (my_row >= 0) { const int ex0_ = my_e & 255, ex1_ = my_e >> 8; const int p0_ = atomicAdd(cnt + ex0_ * CNT_STRIDE, 1), p1_ = atomicAdd(cnt + (32 + ex1_) * CNT_STRIDE, 1); \
        TI[my_row * 4 + 0] = my_e; TI[my_row * 4 + 1] = p0_; TI[my_row * 4 + 2] = p1_; TW[my_row * 2 + 0] = my_w0; TW[my_row * 2 + 1] = my_w1; \
        int* SG_ = (int*)(F.ws + WS_STOKG); SG_[(size_t)ex0_ * GCAP + p0_] = my_row; SG_[(size_t)(32 + ex1_) * GCAP + p1_] = my_row; } my_row = -1; nparked = 0; } while (0)
    f32x4 vn[4];
    if (gw < M) {
#pragma unroll
        for (int j = 0; j < 4; ++j) { const u32x2 q = ((const u32x2*)X1ROW(F.out, gw) + lane)[64 * j]; vn[j] = (f32x4){bflo(q.x), bfhi(q.x), bflo(q.y), bfhi(q.y)}; } }
    for (int row = gw; row < M; row += NGW) {
        const int b = row >> 12;
        f32x4 v[4]; float s = 0.f;
#pragma unroll
        for (int j = 0; j < 4; ++j) v[j] = vn[j];
        if (row + NGW < M) {
#pragma unroll
            for (int j = 0; j < 4; ++j) { const u32x2 q = ((const u32x2*)X1ROW(F.out, row + NGW) + lane)[64 * j]; vn[j] = (f32x4){bflo(q.x), bfhi(q.x), bflo(q.y), bfhi(q.y)}; } }
#pragma unroll
        for (int j = 0; j < 4; ++j) s += (v[j].x * v[j].x + v[j].y * v[j].y) + (v[j].z * v[j].z + v[j].w * v[j].w);
        const float rinv = 1.f / sqrtf(wave_sum(s) * (1.f / D) + NORM_EPS);
        unsigned* o8 = (unsigned*)((unsigned char*)H2 + (size_t)row * D) + lane;
#pragma unroll
        for (int j = 0; j < 4; ++j) { const int k = 256 * j + 4 * lane;
            const f32x4 w = *(const f32x4*)(nw + k), sh = *(const f32x4*)(mod + b * 6144 + 3072 + k), scv = *(const f32x4*)(mod + b * 6144 + 4096 + k);
            v[j] = (v[j] * rinv) * w * (scv + 1.f) + sh;
            o8[64 * j] = pk4f8(v[j].x, v[j].y, v[j].z, v[j].w); }
        float gl[4];
#pragma unroll
        for (int e = 0; e < 4; ++e) { float a = 0.f;
#pragma unroll
            for (int j = 0; j < 4; ++j) { const f32x4 w = *(const LAS f32x4*)(WL + e * 1024 + 256 * j + 4 * lane); a += (v[j].x * w.x + v[j].y * w.y) + (v[j].z * w.z + v[j].w * w.w); }
            gl[e] = wave_sum(a) + BL[e]; }
        int gs = 0; float gm = gl[0];
#pragma unroll
        for (int e = 1; e < 4; ++e) if (gl[e] > gm) { gm = gl[e]; gs = e; }
        float den = 0.f;
#pragma unroll
        for (int e = 0; e < 4; ++e) den += __expf(gl[e] - gm);
        const float gprob = 1.f / den;
        float el[8];
#pragma unroll
        for (int e = 0; e < 8; ++e) { float a = 0.f; const LAS float* wp = WL + (4 + gs * 8 + e) * 1024;
#pragma unroll
            for (int j = 0; j < 4; ++j) { const f32x4 w = *(const LAS f32x4*)(wp + 256 * j + 4 * lane); a += (v[j].x * w.x + v[j].y * w.y) + (v[j].z * w.z + v[j].w * w.w); }
            el[e] = wave_sum(a) + BL[4 + gs * 8 + e]; }
        int i0 = 0; float v0 = el[0];
#pragma unroll
        for (int e = 1; e < 8; ++e) if (el[e] > v0) { v0 = el[e]; i0 = e; }
        int i1 = -1; float v1 = -3.0e38f;
#pragma unroll
        for (int e = 0; e < 8; ++e) if (e != i0 && el[e] > v1) { v1 = el[e]; i1 = e; }
        const float e1 = __expf(v1 - v0); const float w0 = gprob / (1.f + e1), w1 = gprob * e1 / (1.f + e1);
        if (lane == nparked) { my_e = (gs * 8 + i0) | ((gs * 8 + i1) << 8); my_row = row; my_w0 = w0; my_w1 = w1; }
        if (++nparked == 64) ROUTER_FLUSH();
    }
    ROUTER_FLUSH();
#undef ROUTER_FLUSH
}
__device__ __forceinline__ void phase_router(Frame& F) {
    if (F.G != 256) { phase_router_generic(F); return; }
    LAS float* WL = (LAS float*)F.lds;
    LAS float* BL = (LAS float*)(F.lds + 36 * 1024 * 4);
    LAS float* CS = (LAS float*)(F.lds + 36 * 1024 * 4 + 256); LAS float* SH = CS + 1024;
    const float* WR = (const float*)(F.ws + WS_ROUT); const float* mod = (const float*)(F.ws + WS_MOD); const float* nw = F.in[I_N2W];
    const int b = F.vcu >> 4, lane = F.lane;
    { f32x4 wq[18];
#pragma unroll
      for (int q = 0; q < 18; ++q) wq[q] = ((const f32x4*)WR)[F.tid + q * NTHR];
#pragma unroll
      for (int q = 0; q < 18; ++q) ((LAS f32x4*)WL)[F.tid + q * NTHR] = wq[q]; }
    if (F.tid < 36) BL[F.tid] = F.tid < 4 ? F.in[I_BG][F.tid] : F.in[I_BE][F.tid - 4];
    for (int i = F.tid; i < 1024; i += NTHR) { CS[i] = nw[i] * (1.f + mod[b * 6144 + 4096 + i]); SH[i] = mod[b * 6144 + 3072 + i]; }
    __syncthreads();
    bf16* H2 = (bf16*)(F.ws + WS_H2); int* TI = (int*)(F.ws + WS_TI); float* TW = (float*)(F.ws + WS_TW); int* cnt = (int*)(F.ws + WS_CTL);
    if (F.vcu == 0 && F.wave == 0) { u32x4* z = (u32x4*)((unsigned char*)H2 + (size_t)M * D) + lane; z[0] = (u32x4){0u, 0u, 0u, 0u}; }
    const int rg = lane >> 4, kl = lane & 15;
    const int rbase = F.vcu * 256 + F.wave * 32;
    int my_e = 0, my_row = -1; float my_w0 = 0.f, my_w1 = 0.f;
#pragma unroll 1
    for (int it = 0; it < 8; ++it) {
        const int row = rbase + 4 * it + rg;
        int klv = kl; asm volatile("" : "+v"(klv));
        f32x4 v[16]; float s = 0.f;
#pragma unroll
        for (int j = 0; j < 16; ++j) { const u32x2 q = ((const u32x2*)X1ROW(F.out, row) + klv)[16 * j]; v[j] = (f32x4){bflo(q.x), bfhi(q.x), bflo(q.y), bfhi(q.y)}; }
#pragma unroll
        for (int j = 0; j < 16; ++j) s += (v[j].x * v[j].x + v[j].y * v[j].y) + (v[j].z * v[j].z + v[j].w * v[j].w);
        const float rinv = frsq(red16(s) * (1.f / D) + NORM_EPS);
        int rowv = row; asm volatile("" : "+v"(rowv) :: "memory");
        unsigned* o8 = (unsigned*)((unsigned char*)H2 + (size_t)rowv * D) + klv;
#pragma unroll
        for (int j = 0; j < 16; ++j) { const f32x4 c4 = *(const LAS f32x4*)(CS + 64 * j + 4 * klv), s4 = *(const LAS f32x4*)(SH + 64 * j + 4 * klv);
            v[j] = (v[j] * rinv) * c4 + s4;
            o8[16 * j] = pk4f8(v[j].x, v[j].y, v[j].z, v[j].w); }
#define RT_DOT(acc_, wp_) do { float a_ = 0.f; _Pragma("unroll") for (int hh_ = 0; hh_ < 2; ++hh_) { f32x4 w_[8]; \
            _Pragma("unroll") for (int j = 0; j < 8; ++j) w_[j] = *(const LAS f32x4*)((wp_) + 64 * (8 * hh_ + j) + 4 * klv); \
            asm volatile("" :: "v"(w_[0]), "v"(w_[1]), "v"(w_[2]), "v"(w_[3]), "v"(w_[4]), "v"(w_[5]), "v"(w_[6]), "v"(w_[7])); \
            _Pragma("unroll") for (int j = 0; j < 8; ++j) { const f32x4 x_ = v[8 * hh_ + j]; a_ += (x_.x * w_[j].x + x_.y * w_[j].y) + (x_.z * w_[j].z + x_.w * w_[j].w); } } (acc_) = a_; } while (0)
        float gl[4];
#pragma unroll
        for (int e = 0; e < 4; ++e) { float a; RT_DOT(a, WL + e * 1024); gl[e] = red16(a) + BL[e]; }
        int gs = 0; float gm = gl[0];
#pragma unroll
        for (int e = 1; e < 4; ++e) if (gl[e] > gm) { gm = gl[e]; gs = e; }
        float den = 0.f;
#pragma unroll
        for (int e = 0; e < 4; ++e) den += __expf(gl[e] - gm);
        const float gprob = frcp(den);
        float el[8];
#pragma unroll
        for (int e = 0; e < 8; ++e) { float a; const LAS float* wp = WL + (4 + gs * 8 + e) * 1024; RT_DOT(a, wp); el[e] = red16(a) + BL[4 + gs * 8 + e]; }
#undef RT_DOT
        int i0 = 0; float v0 = el[0];
#pragma unroll
        for (int e = 1; e < 8; ++e) if (el[e] > v0) { v0 = el[e]; i0 = e; }
        int i1 = -1; float v1 = -3.0e38f;
#pragma unroll
        for (int e = 0; e < 8; ++e) if (e != i0 && el[e] > v1) { v1 = el[e]; i1 = e; }
        const float e1 = __expf(v1 - v0); const float r1 = frcp(1.f + e1); const float w0 = gprob * r1, w1 = gprob * e1 * r1;
        if (kl == it) { my_e = (gs * 8 + i0) | ((gs * 8 + i1) << 8); my_row = row; my_w0 = w0; my_w1 = w1; }
    }
    LAS int* lc = (LAS int*)(F.lds + 36 * 1024 * 4 + 256 + 8192);
    __syncthreads();
    const int tidp = F.wave * 64 + pg8::lane_id_rebuilt();
    if (tidp < 64) lc[tidp] = 0;
    __syncthreads();
    int lp0 = 0, lp1 = 0; const int ex0 = my_e & 255, ex1 = my_e >> 8;
    if (my_row >= 0) { lp0 = atomicAdd((int*)(lc + ex0), 1); lp1 = atomicAdd((int*)(lc + 32 + ex1), 1); }
    __syncthreads();
    if (tidp < 64) { const int c = lc[tidp]; lc[64 + tidp] = c ? atomicAdd(cnt + tidp * CNT_STRIDE, c) : 0; }
    __syncthreads();
    if (my_row >= 0) { const int p0 = lc[64 + ex0] + lp0, p1 = lc[64 + 32 + ex1] + lp1;
        TI[my_row * 4 + 0] = my_e; TI[my_row * 4 + 1] = p0; TI[my_row * 4 + 2] = p1; TW[my_row * 2 + 0] = my_w0; TW[my_row * 2 + 1] = my_w1;
        int* SG = (int*)(F.ws + WS_STOKG); SG[(size_t)ex0 * GCAP + p0] = my_row; SG[(size_t)(32 + ex1) * GCAP + p1] = my_row; }
}
__device__ __forceinline__ void phase_dispatch(Frame& F) {
    build_tstart(F);
    const LAS int* ts = (const LAS int*)(F.lds + TS_OFF);
    const int* TI = (const int*)(F.ws + WS_TI); const float* TW = (const float*)(F.ws + WS_TW); int* STOK = (int*)(F.ws + WS_STOK); float* SW = (float*)(F.ws + WS_SW); const int* cnt = (const int*)(F.ws + WS_CTL);
    for (int row = F.bid * NTHR + F.tid; row < M; row += F.G * NTHR) {
        const int ee = TI[row * 4 + 0], p0 = TI[row * 4 + 1], p1 = TI[row * 4 + 2];
        const int s0 = ts[ee & 255] * 256 + p0, s1 = ts[32 + (ee >> 8)] * 256 + p1;
        STOK[s0] = row; STOK[s1] = row; SW[s0] = TW[row * 2]; SW[s1] = TW[row * 2 + 1];
    }
    for (int g = 0; g < 64; ++g) { const int c = ts[65 + g], base = ts[g] * 256, n = ((c + 255) & ~255) - c;
        for (int i = F.bid * NTHR + F.tid; i < n; i += F.G * NTHR) { STOK[base + c + i] = M; SW[base + c + i] = 0.f; } }
}
__device__ __forceinline__ void phase_combine(Frame& F) {
    build_tstart(F);
    const LAS int* ts = (const LAS int*)(F.lds + TS_OFF);
    const int gw = F.vcu * NWAVES + F.wave, NGW = F.G * NWAVES, lane = F.lane;
    const int* TI = (const int*)(F.ws + WS_TI); const bf16* YS = (const bf16*)(F.ws + WS_HG); const float* mod = (const float*)(F.ws + WS_MOD); const float* TW = (const float*)(F.ws + WS_TW);
    typedef int i32x4 __attribute__((ext_vector_type(4)));
    const int per = (M + NGW - 1) / NGW, r0 = gw * per, r1 = (r0 + per < M) ? r0 + per : M;
    f32x4 g2r[4]; int cur_b = -1;
    u32x4 yA0, yB0, yA1, yB1, yA2, yB2, x0[2], x1[2], x2[2];
    typedef float f32x2_ __attribute__((ext_vector_type(2)));
#define CMB_LOAD(yA_, yB_, xo_, i_) do { const size_t s0_ = (size_t)__builtin_amdgcn_readlane(s0L, (i_)), s1_ = (size_t)__builtin_amdgcn_readlane(s1L, (i_)); const size_t row_ = (size_t)(sg + (i_)); \
        xo_[0] = ((const u32x4*)X1ROW(F.out, row_) + 2 * lane)[0]; xo_[1] = ((const u32x4*)X1ROW(F.out, row_) + 2 * lane)[1]; \
        asm volatile("" ::: "memory");                          \
        yA_ = ((const u32x4*)((const unsigned char*)YS + s0_ * 1024) + lane)[0]; yB_ = ((const u32x4*)((const unsigned char*)YS + s1_ * 1024) + lane)[0]; } while (0)
#define CMB_PROC(yA_, yB_, xo_, i_) do { const int row_ = sg + (i_); const int b_ = row_ >> 12; \
        if (b_ != cur_b) { cur_b = b_; _Pragma("unroll") for (int q = 0; q < 4; ++q) g2r[q] = ((const f32x4*)(mod + b_ * 6144 + 5120) + 4 * lane)[q]; \
            _Pragma("unroll") for (int j = 0; j < 4; ++j) asm volatile("" : "+v"(g2r[j])); }     \
        const float tw0_ = __uint_as_float(__builtin_amdgcn_readlane(__float_as_uint(twL.x), (i_))) * (1.f / W2_SCALE), tw1_ = __uint_as_float(__builtin_amdgcn_readlane(__float_as_uint(twL.y), (i_))) * (1.f / W2_SCALE); \
        f32x4* o_ = (f32x4*)(F.out + (size_t)row_ * D) + 4 * lane; \
        _Pragma("unroll") for (int q = 0; q < 4; ++q) { const int aw = (int)(yA_)[q], cw = (int)(yB_)[q]; \
            const f32x2_ a01 = __builtin_amdgcn_cvt_pk_f32_fp8(aw, false), a23 = __builtin_amdgcn_cvt_pk_f32_fp8(aw, true), c01 = __builtin_amdgcn_cvt_pk_f32_fp8(cw, false), c23 = __builtin_amdgcn_cvt_pk_f32_fp8(cw, true); \
            const u32x4 xb = xo_[q >> 1]; const unsigned xw0 = (q & 1) ? xb.z : xb.x, xw1 = (q & 1) ? xb.w : xb.y; \
            const f32x4 xv = {bflo(xw0), bfhi(xw0), bflo(xw1), bfhi(xw1)}; \
            const f32x4 mo = {tw0_ * a01.x + tw1_ * c01.x, tw0_ * a01.y + tw1_ * c01.y, tw0_ * a23.x + tw1_ * c23.x, tw0_ * a23.y + tw1_ * c23.y}; \
            o_[q] = xv + g2r[q] * mo; } } while (0)
    for (int sg = r0; sg < r1; sg += 64) {
        const int n = r1 - sg < 64 ? r1 - sg : 64;
        i32x4 tiL = {0, 0, 0, 0}; f32x2 twL = {0.f, 0.f};
        if (lane < n) { tiL = *(const i32x4*)(TI + (size_t)(sg + lane) * 4); twL = *(const f32x2*)(TW + (size_t)(sg + lane) * 2); }
        const int s0L = ts[tiL.x & 255] * 256 + tiL.y, s1L = ts[32 + ((tiL.x >> 8) & 31)] * 256 + tiL.z;
        int i = 0;
        if (n >= 5) {
            CMB_LOAD(yA0, yB0, x0, 0); CMB_LOAD(yA1, yB1, x1, 1);
#pragma unroll 1
            for (; i + 4 < n; i += 3) { CMB_LOAD(yA2, yB2, x2, i + 2); CMB_PROC(yA0, yB0, x0, i); CMB_LOAD(yA0, yB0, x0, i + 3); CMB_PROC(yA1, yB1, x1, i + 1); CMB_LOAD(yA1, yB1, x1, i + 4); CMB_PROC(yA2, yB2, x2, i + 2); }
        } else { if (0 < n) CMB_LOAD(yA0, yB0, x0, 0); if (1 < n) CMB_LOAD(yA1, yB1, x1, 1); }
#pragma unroll 1
        for (; i < n; i += 3) {
            if (i + 2 < n) CMB_LOAD(yA2, yB2, x2, i + 2);
            CMB_PROC(yA0, yB0, x0, i);
            if (i + 1 < n) { if (i + 3 < n) CMB_LOAD(yA0, yB0, x0, i + 3); CMB_PROC(yA1, yB1, x1, i + 1); }
            if (i + 2 < n) { if (i + 4 < n) CMB_LOAD(yA1, yB1, x1, i + 4); CMB_PROC(yA2, yB2, x2, i + 2); }
        }
    }
#undef CMB_LOAD
#undef CMB_PROC
}

constexpr int NPHASE = 11;
constexpr int DUP = 0;
__global__ void __launch_bounds__(NTHR, 2) fwd(Args args) {
    extern __shared__ __attribute__((aligned(16))) unsigned char lds_raw[];
    cg::grid_group grid = cg::this_grid();
    Frame F;
    int wave0 = __builtin_amdgcn_readfirstlane((int)threadIdx.x >> 6); asm volatile("" : "+s"(wave0));
    F.lds = (LAS unsigned char*)lds_raw; F.wave = wave0; F.lane = pg8::lane_id(); F.tid = wave0 * 64 + F.lane;
    F.G = gridDim.x; F.bid = blockIdx.x; F.vcu = (F.G % 8 == 0) ? (F.bid % 8) * (F.G / 8) + F.bid / 8 : F.bid;
    F.in = args.in; F.out = args.out; F.ws = args.ws;
    const int lo = args.ph_lo, hi = args.ph_hi;
#define REFRESH() do { int w_ = wave0; asm volatile("" : "+s"(w_)); F.wave = w_; F.lane = pg8::lane_id(); F.tid = w_ * 64 + F.lane; } while (0)
#define REFRESH_LATE() do { int w_ = wave0; asm volatile("" : "+s"(w_)); F.wave = w_; F.lane = pg8::lane_id_rebuilt(); F.tid = w_ * 64 + F.lane; } while (0)
#define IN(k) (lo <= (k) && (k) < hi)
    if (F.tid < 16) ((LAS unsigned*)(F.lds + MISC_OFF))[F.tid] = 0u;
    __syncthreads();
    XcdBarrier bar = xcd_barrier_post((unsigned*)(F.ws + WS_CTL) + CW_BAR, (volatile LAS unsigned*)(F.lds + MISC_OFF), wave0);
    if (lo < 0) grid.sync();
#define SEAM(k) do { if (IN(k) && IN((k) + 1)) xcd_barrier(bar); } while (0)
    if (IN(0)) { REFRESH(); for (int rep = 0; rep < (DUP == 6 ? 2 : 1); ++rep) { phase_mod(F); phase_convert(F); __syncthreads(); } } SEAM(0);
    if (IN(1)) { REFRESH(); for (int rep = 0; rep < (DUP == 6 ? 2 : 1); ++rep) phase_norm1(F); } SEAM(1);
    if (IN(2)) { REFRESH();
        { pg8::Gemm g{(const pg8::bf16_t*)(F.ws + WS_HX), (const pg8::bf16_t*)(F.ws + WS_WIN), MT, 2048, D, nullptr, F.wave}; pg8::StaticOrder S; S.init(MT, 2048, F.G, F.bid);
          pg8::EpiBf16<0> E{(pg8::bf16_t*)(F.ws + WS_PX), 512, nullptr, 512, U / 2, 1.f};
          pg8::gemm_phase<pg8::EpiBf16<0>, pg8::StaticOrder, true, true>(F.lds, g, S, E); if (DUP == 3) { __syncthreads(); pg8::gemm_phase<pg8::EpiBf16<0>, pg8::StaticOrder, true, true>(F.lds, g, S, E); } }
        __syncthreads();
        { pg8::Gemm g{(const pg8::bf16_t*)(F.ws + WS_HX8), (const pg8::bf16_t*)(F.ws + WS_WIN8), MT, 1536, D / 2, nullptr, F.wave}; pg8::StaticOrder S; S.init(MT, 1536, F.G, F.G - 1 - F.bid);
          pg8::EpiBf16<0> E{(pg8::bf16_t*)(F.ws + WS_PX + 4 * U), 512, nullptr, 512, U / 2, 1.f, 1.f / WI_SCALE};
          pg8::gemm_phase<pg8::EpiBf16<0>, pg8::StaticOrder, true, true, false, true>(F.lds, g, S, E); if (DUP == 3) { __syncthreads(); pg8::gemm_phase<pg8::EpiBf16<0>, pg8::StaticOrder, true, true, false, true>(F.lds, g, S, E); } }
    } SEAM(2);
    if (IN(3)) { REFRESH(); phase_prep(F); phase_vt8(F); } SEAM(3);
    if (IN(4)) { REFRESH();
        for (int rep = 0; rep < (DUP == 1 ? 2 : 1); ++rep) for (int s = F.bid; s < 256; s += F.G) scan::run(F, s);
        REFRESH_LATE();
        float lam;
        { const float s1 = wave_sum(F.in[I_LQ1][F.lane] * F.in[I_LK1][F.lane]), s2 = wave_sum(F.in[I_LQ2][F.lane] * F.in[I_LK2][F.lane]); lam = __expf(s1) - __expf(s2) + 0.2f; }
        for (int rep = 0; rep < (DUP == 2 ? 2 : 1); ++rep)
        if (F.G == 256) { for (int i = 0; i < 4; ++i) { const int u = F.vcu * 4 + i, un = u + 1; att::unit(F, u >> 6, (u >> 4) & 3, u & 15, lam, i > 0, i < 3, un >> 6, (un >> 4) & 3); } }
        else for (int u = F.bid; u < 1024; u += F.G) { const int un = u + F.G; att::unit(F, u >> 6, (u >> 4) & 3, u & 15, lam, u != F.bid, un < 1024, un >> 6, (un >> 4) & 3); }
    } SEAM(4);
    if (IN(5)) { REFRESH_LATE(); pg8::Gemm g{(const pg8::bf16_t*)(F.ws + WS_OCAT), (const pg8::bf16_t*)(F.ws + WS_WOUT), M, D, 1536 / 2, nullptr, F.wave}; pg8::StaticOrder S; S.init(M, D, F.G, F.bid);
        EpiWout E{F.in[I_X], F.out, (const float*)(F.ws + WS_MOD)};
        pg8::gemm_phase<EpiWout, pg8::StaticOrder, true, true, false, true>(F.lds, g, S, E); if (DUP == 3) { __syncthreads(); pg8::gemm_phase<EpiWout, pg8::StaticOrder, true, true, false, true>(F.lds, g, S, E); } } SEAM(5);
    if (IN(6)) { REFRESH_LATE(); phase_router(F); }
    if (IN(6) && IN(8)) xcd_barrier(bar);
    if (IN(8)) { REFRESH_LATE(); build_tstart(F); const LAS int* ts = (const LAS int*)(F.lds + TS_OFF);
        pg8::Gemm g{(const pg8::bf16_t*)(F.ws + WS_H2), (const pg8::bf16_t*)(F.ws + WS_B1), MAXSLOT, 32 * 1024, D / 2, (const int*)(F.ws + WS_STOK), F.wave};
        GroupedOrder S{ts, 0, ts[64] * 4, F.G, F.vcu, (const int*)(F.ws + WS_STOKG)}; EpiSwiGLU E{(bf16*)(F.ws + WS_HID)};
        pg8::gemm_phase<EpiSwiGLU, GroupedOrder, true, true, true, true>(F.lds, g, S, E); } SEAM(8);
    if (IN(9)) { REFRESH_LATE(); build_tstart(F); const LAS int* ts = (const LAS int*)(F.lds + TS_OFF);
        pg8::Gemm g{(const pg8::bf16_t*)(F.ws + WS_HID), (const pg8::bf16_t*)(F.ws + WS_B2), MAXSLOT, 32 * 1024, 256, nullptr, F.wave};
        GroupedOrder S{ts, 0, ts[64] * 4, F.G, F.vcu}; EpiYS E{(bf16*)(F.ws + WS_HG), (const float*)(F.ws + WS_SW)};
        pg8::gemm_phase<EpiYS, GroupedOrder, true, true, false, true>(F.lds, g, S, E); } SEAM(9);
    if (IN(10)) { REFRESH_LATE(); phase_combine(F); }
#undef IN
#undef SEAM
}

extern "C" void kernel_launch(void* const* d_in, const int* in_sizes, int n_in, void* d_out, int out_size, void* d_ws, size_t ws_size, hipStream_t stream) {
    static int grid = 0;
    if (grid == 0) {
        int dev = 0, cus = 0, per_cu = 0;
        hipGetDevice(&dev);
        hipDeviceGetAttribute(&cus, hipDeviceAttributeMultiprocessorCount, dev);
        hipFuncSetAttribute((const void*)fwd, hipFuncAttributeMaxDynamicSharedMemorySize, LDS_BYTES);
        hipOccupancyMaxActiveBlocksPerMultiprocessor(&per_cu, (const void*)fwd, NTHR, LDS_BYTES);
        if (n_in != 35 || ws_size < WS_END || per_cu < 1) { fprintf(stderr, "kernel_launch: unexpected n_in %d / ws %zu / per_cu %d\n", n_in, ws_size, per_cu); }
        grid = cus;
        (void)hipGetLastError();
    }
    hipMemsetAsync((char*)d_ws + WS_CTL, 0, CTL_BYTES, stream);
    Args a{};
    for (int i = 0; i < 35; ++i) a.in[i] = (const float*)d_in[i];
    a.out = (float*)d_out; a.ws = (unsigned char*)d_ws; a.ph_lo = 0; a.ph_hi = NPHASE;
    void* kargs[] = {&a};
    hipError_t e = hipLaunchCooperativeKernel((const void*)fwd, dim3(grid), dim3(NTHR), kargs, LDS_BYTES, stream);
    if (e != hipSuccess) fprintf(stderr, "cooperative launch failed: %s (grid %d)\n", hipGetErrorString(e), grid);
}
```

```cpp
#include <hip/hip_runtime.h>
#include <hip/hip_cooperative_groups.h>
#include <hip/hip_bf16.h>
#include <cstdio>
#include <cstdint>
namespace cg = cooperative_groups;
namespace pg8 {
#define PG8_LAS __attribute__((address_space(3)))
typedef unsigned short bf16_t;
typedef short bf16x8 __attribute__((ext_vector_type(8)));
typedef float f32x4 __attribute__((ext_vector_type(4)));
typedef unsigned u32x4 __attribute__((ext_vector_type(4)));
typedef int i32x4_t __attribute__((ext_vector_type(4)));
typedef int i32x8_t __attribute__((ext_vector_type(8)));
typedef unsigned u32x4_t __attribute__((ext_vector_type(4)));
constexpr int BM = 256, BK = 64, HALF = 128, HTB = HALF * BK * 2  , STAGE_BYTES = 8 * HTB, NXCD = 8, WGM = 8;

__host__ __device__ __forceinline__ int lds_byte(int r, int c) { const int st = (r >> 4) * 2 + (c >> 5), rr = r & 15, cc = c & 31, ob = rr * 64 + cc * 2; return st * 1024 + (ob ^ (((ob >> 9) & 1) << 5)); }
__host__ __device__ __forceinline__ void stage_rc(int b, int& R, int& C) { const int st = b / 1024, sb = b % 1024, swz = sb ^ (((sb >> 9) & 1) << 5); R = (st >> 1) * 16 + swz / 64; C = (st & 1) * 32 + (swz % 64) / 2; }
__host__ __device__ __forceinline__ int perm32(int rho) { const int n = rho >> 4, i = rho & 15; return 8 * (i >> 2) + 4 * n + (i & 3); }

struct Unit { int pm, pn; int aux = 0; };
struct Gemm { const bf16_t* A; const bf16_t* Bt; int M, N, K; const int* rowmap = nullptr; int wid = 0; };
__device__ __forceinline__ int lane_id() { int l = __builtin_amdgcn_mbcnt_hi(~0u, __builtin_amdgcn_mbcnt_lo(~0u, 0u)); asm volatile("" : "+v"(l)); return l; }
__device__ __forceinline__ int lane_id_rebuilt() { unsigned z = 0u; asm volatile("" : "+v"(z)); return (int)__builtin_amdgcn_mbcnt_hi(~0u, __builtin_amdgcn_mbcnt_lo(~0u, z)); }

struct StaticOrder {
    int nM, nN, nwg, G, c;
    __host__ __device__ void init(int M, int N, int G_, int c_) { nM = M / BM; nN = N / BM; nwg = nM * nN; G = G_; c = c_; }
    __host__ __device__ bool next(int i, Unit& u) const {
        const long L = (long)i * G + c; if (L >= nwg) return false;
        int wgid = (int)L; { const int q = nwg / NXCD, r = nwg % NXCD, xcd = wgid % NXCD, off = wgid / NXCD; wgid = (xcd < r ? xcd * (q + 1) : r * (q + 1) + (xcd - r) * q) + off; }
        const int nig = WGM * nN, gid = wgid / nig, fm = gid * WGM, gsz = (nM - fm) < WGM ? (nM - fm) : WGM;
        u.pm = fm + ((wgid % nig) % gsz); u.pn = (wgid % nig) / gsz; return true;
    }
    __device__ __forceinline__ void a_ready(const Unit&) const {}
    __device__ __forceinline__ void done(const Unit&) const {}
};

__device__ __forceinline__ unsigned cvt_pk_bf16(float lo, float hi) { unsigned r; asm volatile("v_cvt_pk_bf16_f32 %0, %1, %2" : "=v"(r) : "v"(lo), "v"(hi)); return r; }
typedef float f32x2 __attribute__((ext_vector_type(2)));
__device__ __forceinline__ f32x2 gelu_pk(f32x2 v) {
    const f32x2 av = __builtin_elementwise_abs(v), d = av * 0.2316418882f + 1.0f;
    f32x2 t; t.x = __builtin_amdgcn_rcpf(d.x); t.y = __builtin_amdgcn_rcpf(d.y);
    f32x2 q = t * 0.5307027145f + (-0.7265760135f); q = q * t + 0.7107068705f; q = q * t + (-0.142248368f); q = q * t + 0.127414796f; q = q * t;
    const f32x2 s = (v * v) * (-0.72134752044f);
    f32x2 e; e.x = __builtin_amdgcn_exp2f(s.x); e.y = __builtin_amdgcn_exp2f(s.y);
    const f32x2 m = v * (q * e), r = v - m;
    f32x2 o; o.x = v.x < 0.f ? m.x : r.x; o.y = v.y < 0.f ? m.y : r.y; return o;
}

template <int ACT  , bool HM = false  > struct EpiBf16 {
    static constexpr bool PERM = true, AFTER_DRAIN = false; static_assert(ACT == 0 || ACT == 1, "EpiBf16: ACT is 0 (none) or 1 (gelu_pk)");
    bf16_t* O; int ldc; const float* bias; int split_cols; size_t split_stride; float scale0; float gscale = 1.f; int hm_splits = 0, hm_M = 0, hm_Tsh = 0, hm_CTsh = 0;
    __device__ __forceinline__ void operator()(const f32x4 (&acc)[2][2][4][2], const Unit& u, int wr, int wc, int fr, int fq) const {
        const int row0 = u.pm * BM + wr * 64 + fr; int colt = u.pn * BM; bf16_t* base = O;
        float sc = 1.f; bool hm = false; if (split_cols) { const int t = colt / split_cols; base += (size_t)t * split_stride; colt -= t * split_cols; if (t == 0) sc = scale0; hm = HM; } sc *= gscale;
        const int col0 = colt + wc * 32 + 8 * fq, bcol0 = u.pn * BM + wc * 32 + 8 * fq;
        f32x4 bv[2][2];
#pragma unroll
        for (int bj = 0; bj < 2; ++bj)
#pragma unroll
            for (int n = 0; n < 2; ++n) bv[bj][n] = bias ? *(const f32x4*)(bias + bcol0 + bj * HALF + 4 * n) : (f32x4){0.f, 0.f, 0.f, 0.f};
        size_t rstride = ldc, hstep = HALF; bf16_t* p0 = base + (size_t)row0 * ldc + col0;
        if (HM) { const int R0_ = u.pm * BM; const bool isx_ = R0_ < hm_M; const int rr0_ = isx_ ? R0_ : R0_ - hm_M; const int tsh_ = isx_ ? hm_Tsh : hm_CTsh; const int bb_ = rr0_ >> tsh_, t0_ = rr0_ & ((1 << tsh_) - 1);
            rstride = 64; hstep = (size_t)2 << (tsh_ + 6);
            p0 = base + (isx_ ? (size_t)0 : (size_t)hm_M * 512) + ((((size_t)bb_ * 8 + (col0 >> 6)) << tsh_) + t0_ + wr * 64 + fr) * 64 + (col0 & 63); }
#pragma unroll
        for (int ai = 0; ai < 2; ++ai)
#pragma unroll
            for (int m = 0; m < 4; ++m) { bf16_t* rowp = p0 + (size_t)(ai * HALF + m * 16) * rstride;
#pragma unroll
                for (int bj = 0; bj < 2; ++bj) { f32x4 v0 = acc[ai][bj][m][0] + bv[bj][0], v1 = acc[ai][bj][m][1] + bv[bj][1];
                    if (ACT == 1) { f32x2 a = gelu_pk((f32x2){v0[0], v0[1]}), b = gelu_pk((f32x2){v0[2], v0[3]}), c = gelu_pk((f32x2){v1[0], v1[1]}), d = gelu_pk((f32x2){v1[2], v1[3]});
                        v0 = (f32x4){a.x, a.y, b.x, b.y}; v1 = (f32x4){c.x, c.y, d.x, d.y}; }
                    v0 = v0 * sc; v1 = v1 * sc; u32x4 w; w.x = cvt_pk_bf16(v0[0], v0[1]); w.y = cvt_pk_bf16(v0[2], v0[3]); w.z = cvt_pk_bf16(v1[0], v1[1]); w.w = cvt_pk_bf16(v1[2], v1[3]);
                    *(u32x4*)(rowp + bj * hstep) = w; } }
    }
};
__device__ __forceinline__ void glds_sv(const char* sbase, unsigned voff, unsigned lds_dst) {
    asm volatile("s_mov_b32 m0, %2\n\ts_nop 0\n\tglobal_load_lds_dwordx4 %0, %1" :: "v"(voff), "s"(sbase), "s"(lds_dst) : "memory", "m0"); }
template <class Epi, class Sched, bool ALIGN_EPI = false, bool SP2 = false, bool GATHER = false, bool FP8 = false>
__device__ __forceinline__ void gemm_phase(PG8_LAS unsigned char* lds, const Gemm g, const Sched& S, const Epi& E) {
    const int wid = g.wid, lane = lane_id_rebuilt(), tid = wid * 64 + lane, wr = wid >> 2, wc = wid & 3, fr = lane & 15, fq = lane >> 4;
    const int K = g.K, nt = K / BK;
    static_assert(!GATHER || SP2, "GATHER is implemented on the SP2 loop");
    const size_t kstep = (size_t)(BK * 2);
    const size_t hstep = (size_t)HALF * K * 2;
    unsigned voffA[2], voffB[2], vA0[2], vA1[2];
#pragma unroll
    for (int i = 0; i < 2; ++i) { int R, C; stage_rc(tid * 16 + i * 8192, R, C); const int Rb = Epi::PERM ? ((R & ~31) + perm32(R & 31)) : R;
        voffA[i] = (unsigned)(R * K + C) * 2u; voffB[i] = (unsigned)(Rb * K + C) * 2u; vA0[i] = voffA[i]; vA1[i] = voffA[i] + (unsigned)hstep; }
#define PG8_GSLOT(tg_) ((PG8_LAS u32x4_t*)(lds + STAGE_BYTES + 1024 + (tg_) * 16))
#define PG8_GOFF(u_, o0_, o1_) do { const int tg_ = wid * 64 + lane_id_rebuilt(); _Pragma("unroll") for (int _i = 0; _i < 2; ++_i) { int R_, C_; stage_rc(tg_ * 16 + _i * 8192, R_, C_); \
        const int t0_ = S.map_row((u_), R_), t1_ = S.map_row((u_), HALF + R_); \
        o0_[_i] = (unsigned)(t0_ * K + C_) * 2u; o1_[_i] = (unsigned)(t1_ * K + C_) * 2u; } } while (0)
    const size_t tstep = 2 * hstep;
    const unsigned ldsu = (unsigned)(uintptr_t)lds; const unsigned ldsw = (unsigned)wid * 1024u;
    const int aoff = lds_byte(wr * 64 + fr, fq * 8), boff = lds_byte(wc * 32 + fr, fq * 8);
    const int aoffk0 = aoff, aoffk1 = aoff + 1024;
    const int boffk0 = boff, boffk1 = boff + 1024;
#define PG8_SA(b, h) (((b) * 2 + (h)) * HTB)
#define PG8_SB(b, h) ((4 + (b) * 2 + (h)) * HTB)
#define PG8_STAGE(bufoff, gbase, voff) do { _Pragma("unroll") for (int _i = 0; _i < 2; ++_i) \
        glds_sv((const char*)(gbase), (voff)[_i], ldsu + (unsigned)(bufoff) + ldsw + _i * 8192u); } while (0)
#define PG8_CAT8(lo_, hi_) __builtin_shufflevector(__builtin_bit_cast(i32x4_t, lo_), __builtin_bit_cast(i32x4_t, hi_), 0, 1, 2, 3, 4, 5, 6, 7)
#define PG8_LDA(dst, b, h) do { _Pragma("unroll") for (int m = 0; m < 4; ++m) { \
        if constexpr (FP8) dst##8[m] = PG8_CAT8(*(const PG8_LAS bf16x8*)(lds + PG8_SA(b, h) + aoffk0 + m * 2048), *(const PG8_LAS bf16x8*)(lds + PG8_SA(b, h) + aoffk1 + m * 2048)); \
        else { dst[m][0] = *(const PG8_LAS bf16x8*)(lds + PG8_SA(b, h) + aoffk0 + m * 2048); dst[m][1] = *(const PG8_LAS bf16x8*)(lds + PG8_SA(b, h) + aoffk1 + m * 2048); } } } while (0)
#define PG8_LDB(dst, b, h) do { _Pragma("unroll") for (int n = 0; n < 2; ++n) { \
        if constexpr (FP8) dst##8[n] = PG8_CAT8(*(const PG8_LAS bf16x8*)(lds + PG8_SB(b, h) + boffk0 + n * 2048), *(const PG8_LAS bf16x8*)(lds + PG8_SB(b, h) + boffk1 + n * 2048)); \
        else { dst[n][0] = *(const PG8_LAS bf16x8*)(lds + PG8_SB(b, h) + boffk0 + n * 2048); dst[n][1] = *(const PG8_LAS bf16x8*)(lds + PG8_SB(b, h) + boffk1 + n * 2048); } } } while (0)
#define PG8_MMA(ai, bj, At, Bt) do { __builtin_amdgcn_s_setprio(1); _Pragma("unroll") for (int m = 0; m < 4; ++m) _Pragma("unroll") for (int n = 0; n < 2; ++n) { \
        if constexpr (FP8) acc[ai][bj][m][n] = __builtin_amdgcn_mfma_scale_f32_16x16x128_f8f6f4(Bt##8[n], At##8[m], acc[ai][bj][m][n], 0, 0, 0, 0x7F7F7F7F, 0, 0x7F7F7F7F); \
        else { _Pragma("unroll") for (int k = 0; k < 2; ++k) acc[ai][bj][m][n] = __builtin_amdgcn_mfma_f32_16x16x32_bf16(Bt[n][k], At[m][k], acc[ai][bj][m][n], 0, 0, 0); } } \
        __builtin_amdgcn_s_setprio(0); } while (0)
#define PG8_WAIT_V(n) asm volatile("s_waitcnt vmcnt(" #n ")" ::: "memory")
#define PG8_WAIT_L(n) asm volatile("s_waitcnt lgkmcnt(" #n ")" ::: "memory")
#define PG8_BAR __builtin_amdgcn_s_barrier()
#define PG8_SCHED __builtin_amdgcn_sched_barrier(0)
    Unit cur, nxt; int ui = 0;
    if (!S.next(0, cur)) return;
    f32x4 acc[2][2][4][2];
#pragma unroll
    for (int a = 0; a < 2; ++a)
#pragma unroll
        for (int b = 0; b < 2; ++b)
#pragma unroll
            for (int m = 0; m < 4; ++m)
#pragma unroll
                for (int n = 0; n < 2; ++n) acc[a][b][m][n] = (f32x4){0.f, 0.f, 0.f, 0.f};
    bf16x8 At[4][2], B0[2][2], B1[2][2];
    i32x8_t At8[4], B08[2], B18[2];
    (void)At; (void)B0; (void)B1; (void)At8; (void)B08; (void)B18;
    const char* cA = GATHER ? (const char*)g.A : (const char*)g.A + (size_t)cur.pm * tstep; const char* cB = (const char*)g.Bt + (size_t)cur.pn * tstep;
    if constexpr (GATHER) { PG8_GOFF(cur, vA0, vA1); }
    S.a_ready(cur);
    if constexpr (SP2) {
        PG8_STAGE(PG8_SB(0, 0), cB, voffB); PG8_STAGE(PG8_SB(0, 1), cB + hstep, voffB); PG8_STAGE(PG8_SA(0, 0), cA, vA0); PG8_STAGE(PG8_SA(0, 1), cA, vA1);
        if (wr == 1) PG8_BAR;
        PG8_WAIT_V(2); PG8_BAR;
        PG8_STAGE(PG8_SB(1, 0), cB + kstep, voffB); PG8_STAGE(PG8_SA(1, 0), cA + kstep, vA0); PG8_STAGE(PG8_SB(1, 1), cB + hstep + kstep, voffB);
        PG8_WAIT_V(6); PG8_BAR;
    } else {
        PG8_STAGE(PG8_SB(0, 0), cB, voffB); PG8_STAGE(PG8_SA(0, 0), cA, voffA); PG8_STAGE(PG8_SB(0, 1), cB + hstep, voffB); PG8_STAGE(PG8_SA(0, 1), cA + hstep, voffA);
        if (wr == 1) PG8_BAR;
        PG8_WAIT_V(4); PG8_BAR;
        PG8_STAGE(PG8_SB(1, 0), cB + kstep, voffB); PG8_STAGE(PG8_SA(1, 0), cA + kstep, voffA); PG8_STAGE(PG8_SB(1, 1), cB + hstep + kstep, voffB);
        PG8_WAIT_V(6); PG8_BAR;
    }
    for (;;) {
        const bool has_next = S.next(ui + 1, nxt);
        const char* nA = (has_next && !GATHER) ? (const char*)g.A + (size_t)nxt.pm * tstep : cA;
        if constexpr (GATHER) { if (has_next) { unsigned n0_[2], n1_[2]; PG8_GOFF(nxt, n0_, n1_); const int ts_ = wid * 64 + lane_id_rebuilt(); *PG8_GSLOT(ts_) = (u32x4_t){n0_[0], n0_[1], n1_[0], n1_[1]}; } }
        const char* nB = has_next ? (const char*)g.Bt + (size_t)nxt.pn * tstep : cB;
#pragma unroll 1
        for (int t = 0; t < nt; t += 2) {
            const bool last = (t == nt - 2);
            const char* a1 = cA + (size_t)(t + 1) * kstep;
            const char* a2 = last ? nA : cA + (size_t)(t + 2) * kstep; const char* b2 = last ? nB : cB + (size_t)(t + 2) * kstep;
            const char* a3 = a2 + kstep; const char* b3 = b2 + kstep;
            if (last && has_next) S.a_ready(nxt);

            if constexpr (SP2) {
            PG8_LDB(B0, 0, 0); PG8_LDB(B1, 0, 1); PG8_SCHED; PG8_LDA(At, 0, 0); PG8_STAGE(PG8_SA(1, 1), a1, vA1);
            if constexpr (GATHER) { if (last && has_next) { const int tl_ = wid * 64 + lane_id_rebuilt(); const u32x4_t q_ = *PG8_GSLOT(tl_);
                vA0[0] = q_[0]; vA0[1] = q_[1]; vA1[0] = q_[2]; vA1[1] = q_[3]; } }
            PG8_WAIT_V(8); PG8_WAIT_L(0); PG8_BAR; PG8_MMA(0, 0, At, B0); PG8_MMA(0, 1, At, B1); PG8_BAR; PG8_SCHED;
            PG8_LDA(At, 0, 1); PG8_STAGE(PG8_SB(0, 0), b2, voffB); PG8_STAGE(PG8_SB(0, 1), b2 + hstep, voffB); PG8_STAGE(PG8_SA(0, 0), a2, vA0);
            PG8_WAIT_V(8); PG8_WAIT_L(0); PG8_BAR; PG8_MMA(1, 0, At, B0); PG8_MMA(1, 1, At, B1); PG8_BAR; PG8_SCHED;
            PG8_LDB(B0, 1, 0); PG8_LDB(B1, 1, 1); PG8_SCHED; PG8_LDA(At, 1, 0); PG8_STAGE(PG8_SA(0, 1), a2, vA1);
            PG8_WAIT_V(8); PG8_WAIT_L(0); PG8_BAR; PG8_MMA(0, 0, At, B0); PG8_MMA(0, 1, At, B1); PG8_BAR; PG8_SCHED;
            PG8_LDA(At, 1, 1); PG8_STAGE(PG8_SB(1, 0), b3, voffB); PG8_STAGE(PG8_SB(1, 1), b3 + hstep, voffB); PG8_STAGE(PG8_SA(1, 0), a3, vA0);
            PG8_WAIT_V(8); PG8_WAIT_L(0); PG8_BAR; PG8_MMA(1, 0, At, B0); PG8_MMA(1, 1, At, B1); PG8_BAR; PG8_SCHED;
            } else {
            PG8_LDB(B0, 0, 0); PG8_SCHED; PG8_LDA(At, 0, 0); PG8_STAGE(PG8_SA(1, 1), a1 + hstep, voffA);
            PG8_WAIT_L(8); PG8_BAR; PG8_WAIT_L(0); PG8_MMA(0, 0, At, B0); PG8_BAR; PG8_SCHED;
            PG8_LDB(B1, 0, 1); PG8_STAGE(PG8_SB(0, 0), b2, voffB);
            PG8_BAR; PG8_WAIT_L(0); PG8_MMA(0, 1, At, B1); PG8_BAR;
            PG8_LDA(At, 0, 1); PG8_STAGE(PG8_SA(0, 0), a2, voffA);
            PG8_BAR; PG8_WAIT_L(0); PG8_MMA(1, 0, At, B0); PG8_BAR; PG8_SCHED;
            PG8_STAGE(PG8_SB(0, 1), b2 + hstep, voffB);
            PG8_WAIT_V(6); PG8_BAR; PG8_MMA(1, 1, At, B1); PG8_BAR;
            PG8_LDB(B0, 1, 0); PG8_SCHED; PG8_LDA(At, 1, 0); PG8_STAGE(PG8_SA(0, 1), a2 + hstep, voffA);
            PG8_WAIT_L(8); PG8_BAR; PG8_WAIT_L(0); PG8_MMA(0, 0, At, B0); PG8_BAR; PG8_SCHED;
            PG8_LDB(B1, 1, 1); PG8_STAGE(PG8_SB(1, 0), b3, voffB);
            PG8_BAR; PG8_WAIT_L(0); PG8_MMA(0, 1, At, B1); PG8_BAR;
            PG8_LDA(At, 1, 1); PG8_STAGE(PG8_SA(1, 0), a3, voffA);
            PG8_BAR; PG8_WAIT_L(0); PG8_MMA(1, 0, At, B0); PG8_BAR; PG8_SCHED;
            PG8_STAGE(PG8_SB(1, 1), b3 + hstep, voffB);
            PG8_WAIT_V(6); PG8_BAR; PG8_MMA(1, 1, At, B1); PG8_BAR;
            }
        }
        if constexpr (ALIGN_EPI) { if (wr == 0) PG8_BAR; }
        if constexpr (!Epi::AFTER_DRAIN) { const int l_e = lane_id_rebuilt();
            E(acc, cur, wr, wc, l_e & 15, l_e >> 4); S.done(cur); }
        if (!has_next) break;
#pragma unroll
        for (int a = 0; a < 2; ++a)
#pragma unroll
            for (int b = 0; b < 2; ++b)
#pragma unroll
                for (int m = 0; m < 4; ++m)
#pragma unroll
                    for (int n = 0; n < 2; ++n) acc[a][b][m][n] = (f32x4){0.f, 0.f, 0.f, 0.f};
        cur = nxt; cA = nA; cB = nB; ++ui;
        if constexpr (ALIGN_EPI) { if (wr == 1) PG8_BAR; }
    }
    PG8_WAIT_V(0);
    if constexpr (!ALIGN_EPI) { if (wr == 0) PG8_BAR; }
    PG8_BAR;
    if constexpr (Epi::AFTER_DRAIN) { E.fused(acc, cur, wr, wc, fr, fq, lds, wid, lane); S.done(cur); }
#undef PG8_GOFF
#undef PG8_GSLOT
#undef PG8_SA
#undef PG8_SB
#undef PG8_STAGE
#undef PG8_LDA
#undef PG8_LDB
#undef PG8_MMA
#undef PG8_CAT8
#undef PG8_WAIT_V
#undef PG8_WAIT_L
#undef PG8_BAR
#undef PG8_SCHED
}
}

#define LAS __attribute__((address_space(3)))
typedef unsigned short bf16;
typedef float f32x4 __attribute__((ext_vector_type(4)));
typedef float f32x2 __attribute__((ext_vector_type(2)));
typedef float f32x16 __attribute__((ext_vector_type(16)));
typedef short bf16x8 __attribute__((ext_vector_type(8)));
typedef short s16x4 __attribute__((ext_vector_type(4)));
typedef unsigned u32x4 __attribute__((ext_vector_type(4)));
typedef unsigned u32x2 __attribute__((ext_vector_type(2)));

constexpr int NB = 16, T = 4096, CT = 256, D = 1024;
constexpr int M = NB * T;
constexpr int MC = NB * CT;
constexpr int MT = M + MC;
constexpr int NIN = 3584;
constexpr int NWAVES = 8, NTHR = 512;
constexpr int LDS_BYTES = 159744;
constexpr float NORM_EPS = 1e-6f, GN_EPS = 64e-5f;
constexpr float QSCALE = 0.125f * 1.4426950408889634f;
constexpr int MAXSLOT = 147456;

constexpr size_t MiB = 1u << 20;
constexpr size_t U = (size_t)MT * 512 * 2;
constexpr size_t WS_CTL = 0;
constexpr size_t CTL_BYTES = 65536;
constexpr int CW_BAR = 4096;
constexpr int CNT_STRIDE = 32;
constexpr int MISC_OFF = 159744 - 64;
constexpr size_t WS_MOD = 1 * MiB;
constexpr size_t WS_ROUT = WS_MOD + 512 * 1024;
constexpr size_t WS_WIN = 2 * MiB;
constexpr size_t WS_WOUT = 9 * MiB;
constexpr size_t WS_B1 = 12 * MiB;
constexpr size_t WS_B2 = 76 * MiB;
constexpr size_t WS_HX = 108 * MiB;
constexpr size_t WS_PX = 244 * MiB;
constexpr size_t WS_OCAT = 720 * MiB;
constexpr size_t WS_H2 = 108 * MiB;
constexpr size_t WS_HG = 244 * MiB;
constexpr size_t WS_HID = 540 * MiB;
constexpr float WI_SCALE = 32.f;
constexpr size_t WS_HX8 = 720 * MiB;
constexpr size_t WS_WIN8 = 6 * MiB;
constexpr float WO_SCALE = 32.f;
constexpr size_t WS_VT8 = 180 * MiB;
constexpr size_t WS_STOKG = 620 * MiB;
constexpr int GCAP = 65536;
constexpr size_t WS_TI = 700 * MiB;
constexpr size_t WS_TW = 702 * MiB;
constexpr size_t WS_STOK = 704 * MiB;
constexpr size_t WS_SW = 705 * MiB;
constexpr size_t WS_K8 = 820 * MiB;
constexpr size_t WS_END = 912 * MiB;
static_assert(WS_PX + 7 * U <= WS_OCAT, "px");
static_assert(WS_HX + (size_t)MT * 1024 * 2 <= WS_PX, "hx");
static_assert(WS_HG + (size_t)MAXSLOT * 1024 * 2 <= WS_HID && WS_HID + (size_t)MAXSLOT * 512 * 2 <= WS_TI, "moe");

struct Args {
    const float* in[35];
    float* out; unsigned char* ws;
    int ph_lo, ph_hi;
};

struct Frame {
    LAS unsigned char* lds;
    int tid, lane, wave, G, vcu, bid;
    const float* const* in;
    float* out; unsigned char* ws;
};

__device__ __forceinline__ unsigned pk2(float lo, float hi) { typedef float f2_ __attribute__((ext_vector_type(2))); typedef __bf16 b2_ __attribute__((ext_vector_type(2))); f2_ v = {lo, hi}; return __builtin_bit_cast(unsigned, __builtin_convertvector(v, b2_)); }
__device__ __forceinline__ unsigned f2bf(float f) { return pk2(f, 0.f) & 0xffffu; }
__device__ __forceinline__ unsigned pk4f8(float a, float b, float c, float d) { int p = __builtin_amdgcn_cvt_pk_fp8_f32(a, b, 0, false); p = __builtin_amdgcn_cvt_pk_fp8_f32(c, d, p, true); return (unsigned)p; }
constexpr float W1_SCALE = 32.f, W2_SCALE = 16.f;
__device__ __forceinline__ float bflo(unsigned u) { return __builtin_bit_cast(float, u << 16); }
__device__ __forceinline__ float bfhi(unsigned u) { return __builtin_bit_cast(float, u & 0xffff0000u); }
template <int CTRL> __device__ __forceinline__ float dppf(float v) { return __builtin_bit_cast(float, __builtin_amdgcn_mov_dpp(__builtin_bit_cast(int, v), CTRL, 0xf, 0xf, true)); }
__device__ __forceinline__ float red4(float v) { v += dppf<0xB1>(v); v += dppf<0x4E>(v); return v; }
__device__ __forceinline__ float red8(float v) { v = red4(v); v += dppf<0x141>(v); return v; }
__device__ __forceinline__ float red16(float v) { v = red8(v); v += dppf<0x140>(v); return v; }
__device__ __forceinline__ float rdl(float v, int l) { return __builtin_bit_cast(float, __builtin_amdgcn_readlane(__builtin_bit_cast(int, v), l)); }
__device__ __forceinline__ float wave_sum(float v) { v = red16(v); return (rdl(v, 0) + rdl(v, 16)) + (rdl(v, 32) + rdl(v, 48)); }
__device__ __forceinline__ float frcp(float x) { return __builtin_amdgcn_rcpf(x); }
__device__ __forceinline__ float frsq(float x) { return __builtin_amdgcn_rsqf(x); }
#define LDS_WAIT() asm volatile("s_waitcnt lgkmcnt(0)" ::: "memory")
#define VM_WAIT() asm volatile("s_waitcnt vmcnt(0)" ::: "memory")
__device__ __forceinline__ void glds16(const void* gsrc, unsigned lds_dst) { unsigned keep;
    asm volatile("s_mov_b32 %0, m0\n\ts_mov_b32 m0, %2\n\ts_nop 0\n\tglobal_load_lds_dwordx4 %1, off\n\ts_mov_b32 m0, %0" : "=&s"(keep) : "v"(gsrc), "s"(lds_dst) : "memory"); }
#define WAIT_BAR_ALL() asm volatile("s_waitcnt vmcnt(0) lgkmcnt(0)\n\ts_barrier" ::: "memory")


#define XB_TMO      128
#define XB_XCNT(j)  (256  + 64 * (j))
#define XB_XSUB(j)  (1280 + 64 * (j))
#define XB_XGEN(j)  (2304 + 64 * (j))
#define XB_TOP      3328
#define XB_TOPGEN   3392
#define XCD_BAR_WORDS 3456
#define XB_SPIN_CAP (1u << 22)
__device__ __forceinline__ unsigned xb_ld(unsigned* p)              { return __hip_atomic_load(p, __ATOMIC_RELAXED, __HIP_MEMORY_SCOPE_AGENT); }
__device__ __forceinline__ unsigned xb_add(unsigned* p, unsigned v) { return __hip_atomic_fetch_add(p, v, __ATOMIC_RELAXED, __HIP_MEMORY_SCOPE_AGENT); }
__device__ __forceinline__ unsigned xb_xcc_id() { return (unsigned)__builtin_amdgcn_s_getreg((3 << 11) | 20) & 0xFu; }
#define XB_SPIN(cond, bar) do { unsigned _sp = 0; while (cond) { __builtin_amdgcn_s_sleep(1); \
    if ((++_sp & 255u) == 0u) { if (xb_ld(&(bar)[XB_TMO])) break; if (_sp > XB_SPIN_CAP) { atomicAdd(&(bar)[XB_TMO], 1u); break; } } } } while (0)
struct XcdBarrier { unsigned* bar; unsigned x; volatile LAS unsigned* st; int wave; };
__device__ __forceinline__ XcdBarrier xcd_barrier_post(unsigned* bar, volatile LAS unsigned* st, int wave) {
    XcdBarrier b; b.bar = bar; b.x = xb_xcc_id(); b.st = st; b.wave = wave;
    if (wave == 0 && pg8::lane_id_rebuilt() == 0) (void)xb_add(&bar[XB_XCNT(b.x)], 1u);
    return b;
}
__device__ __forceinline__ void xcd_barrier_complete(unsigned* bar, unsigned x, unsigned& nloc, unsigned& nx) {
    const unsigned G = gridDim.x * gridDim.y * gridDim.z;
    unsigned sum, cnt, mine, sp = 0u;
    for (;;) {
        sum = 0u; cnt = 0u; mine = 0u;
#pragma unroll
        for (unsigned j = 0; j < 16; ++j) { const unsigned c = xb_ld(&bar[XB_XCNT(j)]); sum += c; cnt += (c > 0u) ? 1u : 0u; mine = (j == x) ? c : mine; }
        if (sum == G) break;
        __builtin_amdgcn_s_sleep(1);
        if ((++sp & 255u) == 0u) { if (xb_ld(&bar[XB_TMO])) break; if (sp > XB_SPIN_CAP) { atomicAdd(&bar[XB_TMO], 1u); break; } }
    }
    nloc = mine > 0u ? mine : 1u; nx = cnt > 0u ? cnt : 1u;
}
__device__ __forceinline__ void xcd_barrier(const XcdBarrier& b) {
    asm volatile("s_waitcnt vmcnt(0)" ::: "memory");
    __syncthreads();
    if (b.wave == 0 && pg8::lane_id_rebuilt() == 0) {
        unsigned* bar = b.bar;
        __builtin_amdgcn_s_waitcnt(0);
        unsigned nloc = b.st[0], nx = b.st[1];
        if (nloc == 0u) { xcd_barrier_complete(bar, b.x, nloc, nx); b.st[0] = nloc; b.st[1] = nx; }
        const unsigned old = xb_add(&bar[XB_XSUB(b.x)], 1u);
        const unsigned gen = old / nloc;
        if (old + 1u == (gen + 1u) * nloc) {
            __builtin_amdgcn_fence(__ATOMIC_RELEASE, "agent");
            asm volatile("s_waitcnt vmcnt(0)" ::: "memory");
            const unsigned og = xb_add(&bar[XB_TOP], 1u);
            const unsigned tg = og / nx;
            if (og + 1u == (tg + 1u) * nx) xb_add(&bar[XB_TOPGEN], 1u);
            else XB_SPIN(xb_ld(&bar[XB_TOPGEN]) == tg, bar);
            __builtin_amdgcn_fence(__ATOMIC_ACQUIRE, "agent");
            xb_add(&bar[XB_XGEN(b.x)], 1u);
            asm volatile("s_waitcnt vmcnt(0)" ::: "memory");
        } else {
            XB_SPIN(xb_ld(&bar[XB_XGEN(b.x)]) == gen, bar);
            __builtin_amdgcn_fence(__ATOMIC_ACQUIRE, "agent");
            asm volatile("s_waitcnt vmcnt(0)" ::: "memory");
        }
    }
    __syncthreads();
}

enum { I_X = 0, I_C, I_CTX, I_CCTX, I_N1W, I_N2W, I_WMOD, I_BMOD, I_WIN, I_SHIFT, I_W0, I_WUP, I_A0, I_AUP, I_GUP, I_KK, I_KA, I_RK, I_LNW, I_LNB,
       I_QNW, I_KNW, I_LQ1, I_LK1, I_LQ2, I_LK2, I_SUBLN, I_WOUT, I_WG, I_BG, I_WE, I_BE, I_MG, I_MU, I_MD };

__device__ __forceinline__ void phase_mod(Frame& F) {
    LAS float* sc = (LAS float*)F.lds;
    LAS float* red = (LAS float*)(F.lds + 17 * 1024 * 4);
    const float* c = F.in[I_C]; const float* cctx = F.in[I_CCTX]; const float* wmod = F.in[I_WMOD]; const float* bmod = F.in[I_BMOD];
    float* mod = (float*)(F.ws + WS_MOD);
    for (int cb = F.bid; cb < 256; cb += F.G) {
        { float cv[34]; int tq = F.tid; asm volatile("" : "+v"(tq));
#pragma unroll
          for (int q = 0; q < 34; ++q) cv[q] = q < 32 ? c[tq + q * NTHR] : cctx[tq + (q - 32) * NTHR];
#pragma unroll
          for (int q = 0; q < 34; ++q) sc[tq + q * NTHR] = cv[q] * frcp(1.f + __expf(-cv[q])); }
        __syncthreads();
        int tm = F.tid; asm volatile("" : "+v"(tm));
        const int col = tm % 24, kp = tm / 24;
        if (tm < 504) {
            float acc[17];
#pragma unroll
            for (int r = 0; r < 17; ++r) acc[r] = 0.f;
            float wv[49];
#pragma unroll
            for (int i = 0; i < 49; ++i) { const int k = kp + 21 * i; wv[i] = k < 1024 ? wmod[(size_t)k * 6144 + cb * 24 + col] : 0.f; }
#pragma unroll
            for (int i = 0; i < 49; ++i) { const int k = kp + 21 * i; const int kc = k < 1024 ? k : 1023; const float w = wv[i];
#pragma unroll
                for (int r = 0; r < 17; ++r) acc[r] += sc[r * 1024 + kc] * w; }
#pragma unroll
            for (int r = 0; r < 17; ++r) red[(kp * 17 + r) * 24 + col] = acc[r];
        }
        __syncthreads();
        if (F.tid < 408) { const int r = F.tid / 24, cc = F.tid % 24; float s = 0.f;
            for (int p = 0; p < 21; ++p) s += red[(p * 17 + r) * 24 + cc];
            mod[r * 6144 + cb * 24 + cc] = s + bmod[cb * 24 + cc]; }
        __syncthreads();
    }
}
__device__ __forceinline__ void tr_item(const float* W, int N, int k0, int n0, bf16* dst, bf16* dst2, int pitch, LAS float* scr, int lane) {
    float tv_[32];
#pragma unroll
    for (int i = 0; i < 32; ++i) { const int kk = 2 * i + (lane >> 5); tv_[i] = W[(size_t)(k0 + kk) * N + n0 + (lane & 31)]; }
#pragma unroll
    for (int i = 0; i < 32; ++i) { const int kk = 2 * i + (lane >> 5); scr[kk * 33 + (lane & 31)] = tv_[i]; }
    LDS_WAIT(); asm volatile("" ::: "memory");
    const int c = lane & 7;
#pragma unroll
    for (int j = 0; j < 4; ++j) { const int n = (lane >> 3) + 8 * j; const LAS float* s_ = scr + (8 * c) * 33 + n; float s[8 * 33 - 32];
#pragma unroll
        for (int q = 0; q < 8; ++q) s[q * 33] = s_[q * 33];
        asm volatile("" :: "v"(s[0 * 33]), "v"(s[1 * 33]), "v"(s[2 * 33]), "v"(s[3 * 33]), "v"(s[4 * 33]), "v"(s[5 * 33]), "v"(s[6 * 33]), "v"(s[7 * 33]));
        u32x4 o; o.x = pk2(s[0 * 33], s[1 * 33]); o.y = pk2(s[2 * 33], s[3 * 33]); o.z = pk2(s[4 * 33], s[5 * 33]); o.w = pk2(s[6 * 33], s[7 * 33]);
        *(u32x4*)(dst + (size_t)n * pitch + 8 * c) = o;
        if (dst2) *(u32x4*)(dst2 + (size_t)n * pitch + 8 * c) = o; }
    LDS_WAIT(); asm volatile("" ::: "memory");
}
__device__ __forceinline__ void tr_item8(const float* W, int N, int k0, int n0, unsigned char* dst8, int pitch, float sc, LAS float* scr, int lane) {
    float tv_[32];
#pragma unroll
    for (int i = 0; i < 32; ++i) { const int kk = 2 * i + (lane >> 5); tv_[i] = W[(size_t)(k0 + kk) * N + n0 + (lane & 31)]; }
#pragma unroll
    for (int i = 0; i < 32; ++i) { const int kk = 2 * i + (lane >> 5); scr[kk * 33 + (lane & 31)] = tv_[i]; }
    LDS_WAIT(); asm volatile("" ::: "memory");
    const int n = lane >> 1; unsigned char* d8 = dst8 + (size_t)n * pitch;
#pragma unroll
    for (int q = 0; q < 2; ++q) { const int cc = 2 * (lane & 1) + q; const LAS float* sp_ = scr + (16 * cc) * 33 + n; u32x4 o; float s_[16 * 33 - 32];
#pragma unroll
        for (int r = 0; r < 16; ++r) s_[r * 33] = sp_[r * 33];
        asm volatile("" :: "v"(s_[0 * 33]), "v"(s_[1 * 33]), "v"(s_[2 * 33]), "v"(s_[3 * 33]), "v"(s_[4 * 33]), "v"(s_[5 * 33]), "v"(s_[6 * 33]), "v"(s_[7 * 33]),
                     "v"(s_[8 * 33]), "v"(s_[9 * 33]), "v"(s_[10 * 33]), "v"(s_[11 * 33]), "v"(s_[12 * 33]), "v"(s_[13 * 33]), "v"(s_[14 * 33]), "v"(s_[15 * 33]));
        o.x = pk4f8(s_[0 * 33] * sc, s_[1 * 33] * sc, s_[2 * 33] * sc, s_[3 * 33] * sc); o.y = pk4f8(s_[4 * 33] * sc, s_[5 * 33] * sc, s_[6 * 33] * sc, s_[7 * 33] * sc);
        o.z = pk4f8(s_[8 * 33] * sc, s_[9 * 33] * sc, s_[10 * 33] * sc, s_[11 * 33] * sc); o.w = pk4f8(s_[12 * 33] * sc, s_[13 * 33] * sc, s_[14 * 33] * sc, s_[15 * 33] * sc);
        *(u32x4*)(d8 + 16 * cc) = o; }
    LDS_WAIT(); asm volatile("" ::: "memory");
}
__device__ __forceinline__ void phase_convert(Frame& F) {
    LAS float* scr = (LAS float*)(F.lds + F.wave * 8448);
    const int gw = F.vcu * NWAVES + F.wave, NGW = F.G * NWAVES;
    bf16* WIN = (bf16*)(F.ws + WS_WIN); bf16* WOUT = (bf16*)(F.ws + WS_WOUT); bf16* B1 = (bf16*)(F.ws + WS_B1); bf16* B2 = (bf16*)(F.ws + WS_B2);
    constexpr int I_IN = 16 * 112, I_OUT = 16 * 32, I_GU = 32 * 16 * 16, I_DN = 32 * 8 * 32;
    constexpr int NITEMS = I_IN + I_OUT + 2 * I_GU + I_DN;
    for (int it = gw; it < NITEMS; it += NGW) {
        int r = it;
        if (r < I_IN) { const int kb = r / 112, nb = r % 112;
            if (nb < 64) tr_item(F.in[I_WIN], NIN, 64 * kb, 32 * nb, WIN + (size_t)(32 * nb) * 1024 + 64 * kb, nullptr, 1024, scr, F.lane);
            else tr_item8(F.in[I_WIN], NIN, 64 * kb, 32 * nb, F.ws + WS_WIN8 + (size_t)(32 * nb - 2048) * 1024 + 64 * kb, 1024, WI_SCALE, scr, F.lane);
            continue; } r -= I_IN;
        if (r < I_OUT) { const int kb = r / 32, nb = r % 32, k0 = 64 * kb;
            unsigned char* d1 = (unsigned char*)WOUT + (size_t)(32 * nb) * 1536 + (k0 < 512 ? k0 : k0 + 512);
            tr_item8(F.in[I_WOUT], 1024, k0, 32 * nb, d1, 1536, WO_SCALE, scr, F.lane);
            if (k0 < 512) tr_item8(F.in[I_WOUT], 1024, k0, 32 * nb, d1 + 512, 1536, WO_SCALE, scr, F.lane);
            continue; } r -= I_OUT;
        if (r < 2 * I_GU) { const int up = r >= I_GU; if (up) r -= I_GU; const int e = r >> 8, q = r & 255, kb = q >> 4, nb = q & 15, n0 = 32 * nb;
            const float* W = F.in[up ? I_MU : I_MG] + (size_t)e * 1024 * 512;
            tr_item8(W, 512, 64 * kb, n0, (unsigned char*)B1 + ((size_t)e * 1024 + (n0 >> 7) * 256 + up * 128 + (n0 & 127)) * 1024 + 64 * kb, 1024, W1_SCALE, scr, F.lane); continue; } r -= 2 * I_GU;
        { const int e = r >> 8, q = r & 255, kb = q >> 5, nb = q & 31;
          tr_item8(F.in[I_MD] + (size_t)e * 512 * 1024, 1024, 64 * kb, 32 * nb, (unsigned char*)B2 + ((size_t)e * 1024 + 32 * nb) * 512 + 64 * kb, 512, W2_SCALE, scr, F.lane); }
    }
    float* WR = (float*)(F.ws + WS_ROUT);
    for (int i = F.bid * NTHR + F.tid; i < 36 * 1024; i += F.G * NTHR) { const int e = i >> 10, k = i & 1023;
        WR[i] = e < 4 ? F.in[I_WG][k * 4 + e] : F.in[I_WE][k * 32 + (e - 4)]; }
}

__device__ __forceinline__ void phase_norm1(Frame& F) {
    const int gw = F.vcu * NWAVES + F.wave, NGW = F.G * NWAVES;
    const float* mod = (const float*)(F.ws + WS_MOD); bf16* HX = (bf16*)(F.ws + WS_HX);
    const float* nw = F.in[I_N1W];
    const int per = (MT + NGW - 1) / NGW, r0 = gw * per, r1 = (r0 + per < MT) ? r0 + per : MT;
    f32x4 va[4], vb[4], vc[4], cs4[4], sh4[4]; int cur_m = -1;
#define N1_ROW(r_) ((r_) < M ? F.in[I_X] + (size_t)(r_) * D : F.in[I_CTX] + (size_t)((r_) - M) * D)
#define N1_LOAD(buf_, r_) do { _Pragma("unroll") for (int j = 0; j < 4; ++j) buf_[j] = ((const f32x4*)N1_ROW(r_) + F.lane)[64 * j]; } while (0)
#define N1_PROC(buf_, r_) do { const int rr_ = (r_); const int mrow = rr_ < M ? (rr_ >> 12) : 16; float s = 0.f; \
        if (mrow != cur_m) { cur_m = mrow; _Pragma("unroll") for (int j = 0; j < 4; ++j) { const int k = 256 * j + 4 * F.lane; \
            const f32x4 w = *(const f32x4*)(nw + k), scv = *(const f32x4*)(mod + mrow * 6144 + 1024 + k); sh4[j] = *(const f32x4*)(mod + mrow * 6144 + k); cs4[j] = w * (scv + 1.f); } \
            _Pragma("unroll") for (int j = 0; j < 4; ++j) asm volatile("" : "+v"(sh4[j]), "+v"(cs4[j])); }     \
        _Pragma("unroll") for (int j = 0; j < 4; ++j) s += (buf_[j].x * buf_[j].x + buf_[j].y * buf_[j].y) + (buf_[j].z * buf_[j].z + buf_[j].w * buf_[j].w); \
        const float rinv = 1.f / sqrtf(wave_sum(s) * (1.f / D) + NORM_EPS); \
        unsigned long long* o8 = (unsigned long long*)(HX + (size_t)rr_ * D) + F.lane; unsigned* o4 = (unsigned*)(F.ws + WS_HX8 + (size_t)rr_ * D) + F.lane; \
        _Pragma("unroll") for (int j = 0; j < 4; ++j) { const f32x4 y = (buf_[j] * rinv) * cs4[j] + sh4[j]; \
            o8[64 * j] = (unsigned long long)pk2(y.x, y.y) | ((unsigned long long)pk2(y.z, y.w) << 32); o4[64 * j] = pk4f8(y.x, y.y, y.z, y.w); } } while (0)
    int rr = r0;
    if (r1 - r0 >= 5) {
        N1_LOAD(va, rr); N1_LOAD(vb, rr + 1);
#pragma unroll 1
        for (; rr + 4 < r1; rr += 3) { N1_LOAD(vc, rr + 2); N1_PROC(va, rr); N1_LOAD(va, rr + 3); N1_PROC(vb, rr + 1); N1_LOAD(vb, rr + 4); N1_PROC(vc, rr + 2); }
    } else { if (rr < r1) N1_LOAD(va, rr); if (rr + 1 < r1) N1_LOAD(vb, rr + 1); }
#pragma unroll 1
    for (; rr < r1; rr += 3) {
        if (rr + 2 < r1) N1_LOAD(vc, rr + 2);
        N1_PROC(va, rr);
        if (rr + 1 < r1) { if (rr + 3 < r1) N1_LOAD(va, rr + 3); N1_PROC(vb, rr + 1); }
        if (rr + 2 < r1) { if (rr + 4 < r1) N1_LOAD(vb, rr + 4); N1_PROC(vc, rr + 2); }
    }
#undef N1_ROW
#undef N1_LOAD
#undef N1_PROC
}

__device__ __forceinline__ void ld8(const bf16* p, float (&v)[8]) { const u32x4 u = *(const u32x4*)p;
    v[0] = bflo(u.x); v[1] = bfhi(u.x); v[2] = bflo(u.y); v[3] = bfhi(u.y); v[4] = bflo(u.z); v[5] = bfhi(u.z); v[6] = bflo(u.w); v[7] = bfhi(u.w); }
__device__ __forceinline__ void st8(bf16* p, const float (&v)[8]) { u32x4 u; u.x = pk2(v[0], v[1]); u.y = pk2(v[2], v[3]); u.z = pk2(v[4], v[5]); u.w = pk2(v[6], v[7]); *(u32x4*)p = u; }
__device__ __forceinline__ void phase_prep(Frame& F) {
    LAS f32x2* cs = (LAS f32x2*)F.lds;
    for (int i = F.tid; i < 1024; i += NTHR) { const int pos = i >> 4, fi = i & 15; const float inv = powf(10000.f, -(float)(2 * fi) / 32.f); const float ang = (float)pos * inv;
        cs[i] = (f32x2){cosf(ang), sinf(ang)}; }
    __syncthreads();
    const int gw = F.vcu * NWAVES + F.wave, NGW = F.G * NWAVES, lane = F.lane;
    bf16* PL = (bf16*)(F.ws + WS_PX + 3 * U); bf16* PQ = (bf16*)(F.ws + WS_PX + 4 * U); bf16* PKD = (bf16*)(F.ws + WS_PX + 5 * U); bf16* FEAT = (bf16*)(F.ws + WS_HX);
    const float* sw = F.in[I_SHIFT];
    const int c8 = 8 * lane;
    float s0[8], s1[8], s2[8], qw[8], kw[8];
#pragma unroll
    for (int j = 0; j < 8; ++j) { s0[j] = sw[1536 + c8 + j]; s1[j] = sw[2048 + 1536 + c8 + j]; s2[j] = sw[4096 + 1536 + c8 + j]; qw[j] = F.in[I_QNW][(c8 & 63) + j]; kw[j] = F.in[I_KNW][(c8 & 63) + j]; }
    const int fcat = (c8 & 255) >> 6;
    const int qi = (lane & 7) >> 1;
    const int fi0 = 8 * (lane & 1);
    const int per = (MT + NGW - 1) / NGW, r0 = gw * per, r1 = (r0 + per < MT) ? r0 + per : MT;
#define RAW(P_, r_) (*(const u32x4*)((P_) + (size_t)((r_) < 0 ? 0 : ((r_) > MT - 1 ? MT - 1 : (r_))) * 512 + c8))
#define UNP8(u_, v_) do { v_[0] = bflo(u_.x); v_[1] = bfhi(u_.x); v_[2] = bflo(u_.y); v_[3] = bfhi(u_.y); v_[4] = bflo(u_.z); v_[5] = bfhi(u_.z); v_[6] = bflo(u_.w); v_[7] = bfhi(u_.w); } while (0)
#define RAWL(r_) ({ const int rc_ = (r_) < 0 ? 0 : ((r_) > MT - 1 ? MT - 1 : (r_)); const size_t o_ = rc_ < M ? ((size_t)((rc_ >> 12) * 8 + (c8 >> 6)) * T + (rc_ & 4095)) * 64 : (size_t)M * 512 + ((size_t)(((rc_ - M) >> 8) * 8 + (c8 >> 6)) * CT + ((rc_ - M) & 255)) * 64; *(const u32x4*)(PL + o_ + (c8 & 63)); })
    u32x4 uPrev, uCur, uNext, uNext2, uQK[2], uQ1, uK1;
    if (r0 < r1) { uPrev = RAWL(r0 - 1); uCur = RAWL(r0); uNext = RAWL(r0 + 1); uNext2 = RAWL(r0 + 2); uQK[0] = RAW(PQ, r0); uQK[1] = RAW(PKD, r0); uQ1 = RAW(PQ, r0 + 1); uK1 = RAW(PKD, r0 + 1); }
    for (int rr = r0; rr < r1; ++rr) {
        int t, TT; bool isx = rr < M; if (isx) { t = rr & 4095; TT = T; } else { t = (rr - M) & 255; TT = CT; }
        const u32x4 uNext3 = RAWL(rr + 3), uQn = RAW(PQ, rr + 2), uKn = RAW(PKD, rr + 2);
        float a[8], b[8], c[8], f[8];
        UNP8(uPrev, a); UNP8(uCur, b); UNP8(uNext, c);
        const float mp = t > 0 ? 1.f : 0.f, mn = t < TT - 1 ? 1.f : 0.f;
#pragma unroll
        for (int j = 0; j < 8; ++j) { const float z = s0[j] * (mp * a[j]) + s1[j] * b[j] + s2[j] * (mn * c[j]);
            const float r_ = frcp(1.f + __expf(fcat == 0 ? -2.f * z : -z));
            f[j] = fcat == 0 ? 2.f * r_ - 1.f : (fcat == 1 ? z : r_); }
        st8(FEAT + (size_t)(c8 >> 8) * ((size_t)MT * 256) + (size_t)rr * 256 + (c8 & 255), f);
#pragma unroll
        for (int which = 0; which < 2; ++which) {
            bf16* P = (which ? PKD : PQ) + (size_t)rr * 512 + c8;
            float v[8]; UNP8(uQK[which], v);
            float ss = 0.f;
#pragma unroll
            for (int j = 0; j < 8; ++j) ss += v[j] * v[j];
            ss = red8(ss);
            const float rinv = frsq(ss * (1.f / 64.f) + NORM_EPS);
#pragma unroll
            for (int j = 0; j < 8; ++j) v[j] = v[j] * rinv * (which ? kw[j] : qw[j]);
            if (isx) {
                const int pos = qi < 2 ? (t >> 6) : (t & 63);
#pragma unroll
                for (int j = 0; j < 8; ++j) { const float p = dppf<0x4E>(v[j]);
                    const f32x2 csv = cs[pos * 16 + fi0 + j];
                    v[j] = (qi & 1) ? v[j] * csv.x + p * csv.y : v[j] * csv.x - p * csv.y; }
            }
            if (!which) {
#pragma unroll
                for (int j = 0; j < 8; ++j) v[j] *= QSCALE; }
            if (!which) st8(P, v);
            else { int bq, key; if (isx) { bq = rr >> 12; key = CT + t; } else { bq = (rr - M) >> 8; key = t; }
                const int hh = c8 >> 7, mm = (c8 >> 6) & 1, dd = c8 & 63;
                *(u32x2*)(F.ws + WS_K8 + ((((size_t)(bq * 4 + hh) * 2 + mm) * 68 + (key >> 6)) * 64 + (key & 63)) * 80 + dd) = (u32x2){pk4f8(v[0], v[1], v[2], v[3]), pk4f8(v[4], v[5], v[6], v[7])}; }
        }
        uPrev = uCur; uCur = uNext; uNext = uNext2; uNext2 = uNext3; uQK[0] = uQ1; uQK[1] = uK1; uQ1 = uQn; uK1 = uKn;
    }
#undef RAW
#undef RAWL
#undef UNP8
}

namespace scan {
constexpr int TC = 32;
constexpr int O_CL = 0  , O_B = 8192  ,
              O_G = 16384  , O_Y = 32768, O_RHO = 40960  , O_WC_OLD = 41472  , O_WC = 153088  ,
              O_STG = 41984, STG_BYTES = 31744, STG_FEAT = 15360, NSTG = 3  , O_IMGX = O_STG + NSTG * STG_BYTES, O_CT = O_IMGX + 12288;
constexpr int IMG_AT = 0, IMG_RT = 2048, IMG_BT = 4096, IMG_KT = 6144, IMG_QT = 8192, IMG_RTP = 10240, IMG_BH = 12288, IMG_SC = 14336;
constexpr int IMX_KH = 0, IMX_VR = 2048, IMX_AB0 = 4096, IMX_ABR = 5120, IMX_SC = 6144;
constexpr int O_KV1 = 24576  , O_AB1 = 154112  ;
typedef short v4i16_t __attribute__((ext_vector_type(4)));
__device__ __forceinline__ u32x2 trd(const LAS unsigned char* img, int c0, int lane) {
    const int row_ = 4 * (lane >> 4) + ((lane & 15) >> 2);
    const LAS unsigned char* p = img + row_ * 128 + ((((c0 >> 3) + ((lane & 3) >> 1)) ^ (row_ & 7)) << 4) + ((lane & 1) << 3);
    return __builtin_bit_cast(u32x2, __builtin_amdgcn_ds_read_tr16_b64_v4i16((LAS v4i16_t*)p)); }
static_assert(O_KV1 + 8192 <= 32768 && O_AB1 + 4096 <= MISC_OFF && O_WC + 1024 <= O_AB1 && O_CT + 14 * 256 <= O_WC && O_WC + 1024 <= MISC_OFF && O_IMGX + 2 * IMX_SC <= O_CT && 2 * IMG_SC <= STG_BYTES && O_WC_OLD + 512 <= O_STG && O_STG + 32768 <= O_CT, "scan LDS map");
__device__ __forceinline__ int grow(bool isx, int b, int t) { return isx ? b * T + t : M + b * CT + t; }

__device__ __forceinline__ void issue_chunk(Frame& F, int b, int h, int d, bool isx, int t0, int TT, unsigned stg) {
    const bf16* PXB = (const bf16*)(F.ws + WS_PX); const bf16* FEAT = (const bf16*)(F.ws + WS_HX);
    const int lane = F.lane;
#pragma unroll
    for (int pi = 0; pi < 4; ++pi) { const int p = F.wave + 8 * pi;
        if (p < 15) { const int ten = p / 5, rb = p % 5; int j = 8 * rb + (lane >> 3); int t = t0 - 1 + j; t = t < 0 ? 0 : (t > TT - 1 ? TT - 1 : t);
            const bf16* src = PXB + (size_t)ten * (U / 2) + (isx ? ((size_t)(b * 8 + h) * T + t) * 64 : (size_t)M * 512 + ((size_t)(b * 8 + h) * CT + t) * 64) + 8 * (lane & 7);
            glds16(src, (unsigned)__builtin_amdgcn_readfirstlane(stg + ten * 5120 + rb * 1024)); }
        else if (p < 31) { const int q = p - 15; const int jj = 2 * q + (lane >> 5); const int sd = lane & 31;
            const bf16* src = FEAT + (size_t)d * ((size_t)MT * 256) + (size_t)grow(isx, b, t0 + jj) * 256 + 8 * (sd ^ (jj & 15));
            glds16(src, (unsigned)__builtin_amdgcn_readfirstlane(stg + STG_FEAT + q * 1024)); }
    }
}

__device__ __forceinline__ void issue_chunk4(Frame& F, int b, int h, int d, bool isx, int t0, int TT, unsigned stg, int w4  ) {
    const bf16* PXB = (const bf16*)(F.ws + WS_PX); const bf16* FEAT = (const bf16*)(F.ws + WS_HX);
    int lane = F.lane; asm volatile("" : "+v"(lane));
#pragma unroll
    for (int pi = 0; pi < 8; ++pi) { const int p = w4 + 4 * pi;
        if (p < 15) { const int ten = p / 5, rb = p % 5; int j = 8 * rb + (lane >> 3); int t = t0 - 1 + j; t = t < 0 ? 0 : (t > TT - 1 ? TT - 1 : t);
            const bf16* src = PXB + (size_t)ten * (U / 2) + (isx ? ((size_t)(b * 8 + h) * T + t) * 64 : (size_t)M * 512 + ((size_t)(b * 8 + h) * CT + t) * 64) + 8 * (lane & 7);
            glds16(src, (unsigned)__builtin_amdgcn_readfirstlane(stg + ten * 5120 + rb * 1024)); }
        else if (p < 31) { const int q = p - 15; const int jj = 2 * q + (lane >> 5); const int sd = lane & 31;
            const bf16* src = FEAT + (size_t)d * ((size_t)MT * 256) + (size_t)grow(isx, b, t0 + jj) * 256 + 8 * (sd ^ (jj & 15));
            glds16(src, (unsigned)__builtin_amdgcn_readfirstlane(stg + STG_FEAT + q * 1024)); }
    }
}

__device__ __forceinline__ void run(Frame& F, int sidx) {
    const int b = sidx >> 4, h = (sidx >> 1) & 7, d = sidx & 1;
    const int tid = F.tid, lane = F.lane, wave = F.wave;
    LAS unsigned char* L = F.lds; const unsigned lds0 = (unsigned)(uintptr_t)L;
    const int cq = tid & 15, srow = tid >> 4;
    const int ch0 = h * 64 + 4 * cq;
    const int mt = wave >> 2, nt = wave < 4 ? wave : (wave & 1), n = lane & 15, fq = lane >> 4;
    const int chm = h * 64 + 16 * nt + n;
    bf16x8 bw[2], ba[2], bg[4];
    {
        LAS bf16* WL = (LAS bf16*)(L + O_STG);
        WAIT_BAR_ALL();
        { float wv_[32]; const int nn = lane;
#pragma unroll
          for (int it = 0; it < 32; ++it) { const int k = wave + 8 * it;
              wv_[it] = it < 8 ? F.in[I_WUP][(size_t)(d * 64 + k) * 512 + h * 64 + nn] : it < 16 ? F.in[I_AUP][(size_t)(d * 64 + k - 64) * 512 + h * 64 + nn] : F.in[I_GUP][(size_t)(d * 128 + k - 128) * 512 + h * 64 + nn]; }
#pragma unroll
          for (int it = 0; it < 32; ++it) WL[nn * 256 + wave + 8 * it] = (bf16)f2bf(wv_[it]); }
        LDS_WAIT(); __builtin_amdgcn_s_barrier(); asm volatile("" ::: "memory");
        for (int idx = tid; idx < 14 * 64; idx += NTHR) { const int rw = idx >> 6, cc = idx & 63; float v_;
            if (rw < 9) v_ = F.in[I_SHIFT][(rw % 3) * 2048 + (rw / 3) * 512 + h * 64 + cc];
            else v_ = F.in[rw == 9 ? I_KK : rw == 10 ? I_KA : rw == 11 ? I_RK : rw == 12 ? I_LNW : I_LNB][h * 64 + cc];
            *(LAS float*)(L + O_CT + idx * 4) = v_; }
        const LAS bf16* wp = WL + (16 * nt + n) * 256 + 8 * fq;
#pragma unroll
        for (int ks = 0; ks < 2; ++ks) { bw[ks] = *(const LAS bf16x8*)(wp + 32 * ks); ba[ks] = *(const LAS bf16x8*)(wp + 64 + 32 * ks); }
#pragma unroll
        for (int ks = 0; ks < 4; ++ks) bg[ks] = *(const LAS bf16x8*)(wp + 128 + 32 * ks);
        LDS_WAIT(); __builtin_amdgcn_s_barrier(); asm volatile("" ::: "memory");
    }
    const float w0c = F.in[I_W0][d * 512 + chm], a0c = F.in[I_A0][d * 512 + chm];
    f32x4 Sreg[4];
#pragma unroll
    for (int jt = 0; jt < 4; ++jt) Sreg[jt] = (f32x4){0.f, 0.f, 0.f, 0.f};
    bf16* OC = (bf16*)(F.ws + WS_OCAT);

    constexpr int NCH = (CT + T) / TC;
#define CHUNK_GEOM(ci, isx_, t0_, TT_) bool isx_ = (ci) >= CT / TC; const int TT_ = isx_ ? T : CT; const int lc_ = isx_ ? (ci) - CT / TC : (ci); const int t0_ = d ? TT_ - TC * (lc_ + 1) : TC * lc_;
#define PK4(v) ((u32x2){pk2((v)[0], (v)[1]), pk2((v)[2], (v)[3])})
#define READOUT(ci_, vsr_, gvr_) do { CHUNK_GEOM(ci_, isxr_, t0r_, TTr_) (void)TTr_; if (isxr_) { const int jjr_ = d ? TC - 1 - srow : srow; const int tr_ = t0r_ + jjr_; \
        const f32x4 y_ = *(const LAS f32x4*)(L + O_Y + (srow * 64 + 4 * cq) * 4), gv_ = (gvr_); \
        const float rho_ = *(const LAS float*)(L + O_RHO + ((ci_) & 1) * 256 + srow * 4); \
        const f32x4 lnw_ = *(const LAS f32x4*)(L + O_CT + (12 * 64 + 4 * cq) * 4), lnb_ = *(const LAS f32x4*)(L + O_CT + (13 * 64 + 4 * cq) * 4); \
        asm volatile("" :: "v"(y_), "v"(rho_), "v"(lnw_), "v"(lnb_));        \
        const float mu_ = red16((y_[0] + y_[1]) + (y_[2] + y_[3])) * (1.f / 64.f); const f32x4 dy_ = y_ - mu_; \
        const float var_ = red16((dy_[0] * dy_[0] + dy_[1] * dy_[1]) + (dy_[2] * dy_[2] + dy_[3] * dy_[3])) * (1.f / 64.f); const float rstd_ = frsq(var_ + GN_EPS); \
        f32x4 o_; _Pragma("unroll") for (int c = 0; c < 4; ++c) o_[c] = ((dy_[c] * rstd_) * lnw_[c] + lnb_[c] + rho_ * (vsr_)[c]) * gv_[c]; \
        *(unsigned*)((unsigned char*)OC + (size_t)(b * T + tr_) * 1536 + d * 512 + h * 64 + 4 * cq) = pk4f8(__builtin_amdgcn_fmed3f(o_[0], -448.f, 448.f), __builtin_amdgcn_fmed3f(o_[1], -448.f, 448.f), __builtin_amdgcn_fmed3f(o_[2], -448.f, 448.f), __builtin_amdgcn_fmed3f(o_[3], -448.f, 448.f)); } } while (0)
#define LORA_LOAD(af_, mt_, stg_) do { int ll_ = lane; asm volatile("" : "+v"(ll_)); const int jrow_ = 16 * (mt_) + (ll_ & 15); const LAS unsigned char* fb_ = L + (stg_) + STG_FEAT + jrow_ * 512; \
            _Pragma("unroll") for (int ks = 0; ks < 8; ++ks) af_[ks] = *(const LAS bf16x8*)(fb_ + 16 * ((4 * ks + (ll_ >> 4)) ^ (jrow_ & 15))); } while (0)
#define LORA_TILE(af_, mt_, cj_) do { const int mt = (mt_); int ll_ = lane; asm volatile("" : "+v"(ll_)); const int n = ll_ & 15, fq = ll_ >> 4; \
            f32x4 cw = {0.f, 0.f, 0.f, 0.f}, ca = cw, cg_ = cw; \
            _Pragma("unroll") for (int ks = 0; ks < 2; ++ks) cw = __builtin_amdgcn_mfma_f32_16x16x32_bf16(af_[ks], bw[ks], cw, 0, 0, 0); \
            _Pragma("unroll") for (int ks = 0; ks < 2; ++ks) ca = __builtin_amdgcn_mfma_f32_16x16x32_bf16(af_[2 + ks], ba[ks], ca, 0, 0, 0); \
            _Pragma("unroll") for (int ks = 0; ks < 4; ++ks) cg_ = __builtin_amdgcn_mfma_f32_16x16x32_bf16(af_[4 + ks], bg[ks], cg_, 0, 0, 0); \
            f32x4 lw, pf; \
            _Pragma("unroll") for (int r = 0; r < 4; ++r) lw[r] = -0.60653066f * frcp(1.f + __expf(-(w0c + cw[r]))); \
            if (d == 0) { pf[0] = lw[0]; pf[1] = pf[0] + lw[1]; pf[2] = pf[1] + lw[2]; pf[3] = pf[2] + lw[3]; } else { pf[3] = lw[3]; pf[2] = pf[3] + lw[2]; pf[1] = pf[2] + lw[1]; pf[0] = pf[1] + lw[0]; } \
            const float tot = d == 0 ? pf[3] : pf[0]; \
            const int toti_ = __builtin_bit_cast(int, tot);        \
            const float T0 = __builtin_bit_cast(float, __builtin_amdgcn_ds_bpermute(4 * n, toti_)), T1 = __builtin_bit_cast(float, __builtin_amdgcn_ds_bpermute(4 * (n + 16), toti_)), T2 = __builtin_bit_cast(float, __builtin_amdgcn_ds_bpermute(4 * (n + 32), toti_)), T3 = __builtin_bit_cast(float, __builtin_amdgcn_ds_bpermute(4 * (n + 48), toti_)); \
            const float off = d == 0 ? ((fq > 0 ? T0 : 0.f) + (fq > 1 ? T1 : 0.f)) + (fq > 2 ? T2 : 0.f) : ((fq < 3 ? T3 : 0.f) + (fq < 2 ? T2 : 0.f)) + (fq < 1 ? T1 : 0.f); \
            _Pragma("unroll") for (int r = 0; r < 4; ++r) { const int jj = 16 * mt + 4 * fq + r; const int s_ = d ? TC - 1 - jj : jj; const int o = (s_ * 64 + 16 * nt + n) * 4; \
                *(LAS float*)(L + O_CL + o) = pf[r] + off; \
                *(LAS float*)(L + O_B + o) = frcp(1.f + __expf(-(a0c + ca[r]))); \
                *(LAS float*)(L + O_G + o) = cg_[r]; } \
            if (fq == 0) *(LAS float*)(L + O_WC + ((cj_) & 1) * 512 + ((d ? 1 - mt : mt) * 64 + 16 * nt + n) * 4) = __expf((T0 + T1) + (T2 + T3)); \
        } while (0)
#define IMX_KHP(par_, sc_) ((par_) ? L + O_KV1 + (sc_) * 4096 : L + O_IMGX + (sc_) * IMX_SC + IMX_KH)
#define IMX_VRP(par_, sc_) ((par_) ? L + O_KV1 + (sc_) * 4096 + 2048 : L + O_IMGX + (sc_) * IMX_SC + IMX_VR)
#define IMX_AB0P(par_, sc_) ((par_) ? L + O_AB1 + (sc_) * 2048 : L + O_IMGX + (sc_) * IMX_SC + IMX_AB0)
#define IMX_ABRP(par_, sc_) ((par_) ? L + O_AB1 + (sc_) * 2048 + 1024 : L + O_IMGX + (sc_) * IMX_SC + IMX_ABR)
    const int srow0 = (tid >> 4) & 15;
    f32x4 vsA[2], gA[2], rsA[2], ksA[2], kkA[2], g_p1[2], g_p2[2];
#pragma unroll
    for (int hr = 0; hr < 2; ++hr) { vsA[hr] = (f32x4){0.f, 0.f, 0.f, 0.f}; gA[hr] = vsA[hr]; rsA[hr] = vsA[hr]; ksA[hr] = vsA[hr]; kkA[hr] = vsA[hr]; g_p1[hr] = vsA[hr]; g_p2[hr] = vsA[hr]; }
#define READOUT2(ci_) do { CHUNK_GEOM(ci_, isxr_, t0r_, TTr_) (void)TTr_; if (isxr_) { f32x4 y2_[2], vs2_[2]; float rho2_[2]; \
        _Pragma("unroll") for (int hr = 0; hr < 2; ++hr) { const int srow = srow0 + 16 * hr; vs2_[hr] = VS_BACK(ci_, hr); y2_[hr] = *(const LAS f32x4*)(L + O_Y + (srow * 64 + 4 * cq) * 4); rho2_[hr] = *(const LAS float*)(L + O_RHO + ((ci_) & 1) * 256 + srow * 4); } \
        const f32x4 lnw_ = *(const LAS f32x4*)(L + O_CT + (12 * 64 + 4 * cq) * 4), lnb_ = *(const LAS f32x4*)(L + O_CT + (13 * 64 + 4 * cq) * 4); \
        asm volatile("" :: "v"(y2_[0]), "v"(y2_[1]), "v"(vs2_[0]), "v"(vs2_[1]), "v"(rho2_[0]), "v"(rho2_[1]), "v"(lnw_), "v"(lnb_));        \
        _Pragma("unroll") for (int hr = 0; hr < 2; ++hr) { const int srow = srow0 + 16 * hr; const int jjr_ = d ? TC - 1 - srow : srow; const int tr_ = t0r_ + jjr_; const f32x4 y_ = y2_[hr], gv_ = g_p2[hr]; \
        const float mu_ = red16((y_[0] + y_[1]) + (y_[2] + y_[3])) * (1.f / 64.f); const f32x4 dy_ = y_ - mu_; \
        const float var_ = red16((dy_[0] * dy_[0] + dy_[1] * dy_[1]) + (dy_[2] * dy_[2] + dy_[3] * dy_[3])) * (1.f / 64.f); const float rstd_ = frsq(var_ + GN_EPS); \
        f32x4 o_; _Pragma("unroll") for (int c = 0; c < 4; ++c) o_[c] = ((dy_[c] * rstd_) * lnw_[c] + lnb_[c] + rho2_[hr] * vs2_[hr][c]) * gv_[c]; \
        *(unsigned*)((unsigned char*)OC + (size_t)(b * T + tr_) * 1536 + d * 512 + h * 64 + 4 * cq) = pk4f8(__builtin_amdgcn_fmed3f(o_[0], -448.f, 448.f), __builtin_amdgcn_fmed3f(o_[1], -448.f, 448.f), __builtin_amdgcn_fmed3f(o_[2], -448.f, 448.f), __builtin_amdgcn_fmed3f(o_[3], -448.f, 448.f)); } } } while (0)
#define VS_BACK(cj_, hr_) ({ const u32x2 v2_ = *(const LAS u32x2*)(IMX_VRP((cj_) & 1, (hr_)) + srow0 * 128 + (((cq >> 1) ^ (srow0 & 7)) << 4) + ((cq & 1) << 3)); (f32x4){bflo(v2_.x), bfhi(v2_.x), bflo(v2_.y), bfhi(v2_.y)}; })
    { CHUNK_GEOM(0, isx0, t00, TT0) issue_chunk(F, b, h, d, isx0, t00, TT0, lds0 + O_STG); }
    { CHUNK_GEOM(1, isx1, t01, TT1) issue_chunk(F, b, h, d, isx1, t01, TT1, lds0 + O_STG + STG_BYTES); }
    WAIT_BAR_ALL();
    int sbuf = 0;
    for (int ci = 0; ci <= NCH; ++ci) {
        const bool act = ci < NCH; const int cig = act ? ci : NCH - 1;
        CHUNK_GEOM(cig, isx, t0, TT)
        const unsigned stg = O_STG + sbuf * STG_BYTES, stgp = O_STG + (sbuf == 0 ? 2 : sbuf - 1) * STG_BYTES;
        const int pp = (ci - 1) & 1;
        int cqv = cq; asm volatile("" : "+v"(cqv));
        if (wave >= 4) {
            if (ci >= 2) READOUT2(ci - 2);
            if (act) {
#pragma unroll
                for (int mtt = 0; mtt < 2; ++mtt) if (mtt == ((wave >> 1) & 1)) { bf16x8 laf[8]; LORA_LOAD(laf, mtt, stg); LORA_TILE(laf, mtt, ci); }
#pragma unroll
                for (int hr = 0; hr < 2; ++hr) { const int srow = srow0 + 16 * hr;
        {
            const int jj = d ? TC - 1 - srow : srow; const int t = t0 + jj; const int j = jj + 1;
            const LAS unsigned char* sb = L + stg;
            const float mp = t > 0 ? 1.f : 0.f, mn = t < TT - 1 ? 1.f : 0.f;
            float swr[3][4], swk[3][4], swv[3][4];
#pragma unroll
            for (int j3 = 0; j3 < 3; ++j3) { const f32x4 a_ = *(const LAS f32x4*)(L + O_CT + (j3 * 64 + 4 * cqv) * 4), b_ = *(const LAS f32x4*)(L + O_CT + ((3 + j3) * 64 + 4 * cqv) * 4), c_ = *(const LAS f32x4*)(L + O_CT + ((6 + j3) * 64 + 4 * cqv) * 4);
#pragma unroll
                for (int c = 0; c < 4; ++c) { swr[j3][c] = a_[c]; swk[j3][c] = b_[c]; swv[j3][c] = c_[c]; } }
            const f32x4 kk_w = *(const LAS f32x4*)(L + O_CT + (9 * 64 + 4 * cqv) * 4);
#define LD4(ten, row) (*(const LAS u32x2*)(sb + (ten) * 5120 + (row) * 128 + 8 * cq))
#define UNP(u, k) ((k) == 0 ? bflo((u).x) : (k) == 1 ? bfhi((u).x) : (k) == 2 ? bflo((u).y) : bfhi((u).y))
            const u32x2 r0 = LD4(0, j - 1), r1 = LD4(0, j), r2 = LD4(0, j + 1), k0 = LD4(1, j - 1), k1 = LD4(1, j), k2 = LD4(1, j + 1), v0 = LD4(2, j - 1), v1 = LD4(2, j), v2 = LD4(2, j + 1);
            float ss = 0.f;
#pragma unroll
            for (int c = 0; c < 4; ++c) {
                rsA[hr][c] = swr[0][c] * (mp * UNP(r0, c)) + swr[1][c] * UNP(r1, c) + swr[2][c] * (mn * UNP(r2, c));
                ksA[hr][c] = swk[0][c] * (mp * UNP(k0, c)) + swk[1][c] * UNP(k1, c) + swk[2][c] * (mn * UNP(k2, c));
                vsA[hr][c] = swv[0][c] * (mp * UNP(v0, c)) + swv[1][c] * UNP(v1, c) + swv[2][c] * (mn * UNP(v2, c));
                kkA[hr][c] = ksA[hr][c] * kk_w[c]; ss += kkA[hr][c] * kkA[hr][c]; }
            ss = red16(ss);
            kkA[hr] = kkA[hr] * frsq(fmaxf(ss, 1e-24f));
#undef LD4
#undef UNP
        }
                }
            }
        } else {
            if (ci >= 1 && ci + 1 < NCH) { CHUNK_GEOM(ci + 1, isxn, t0n, TTn) issue_chunk4(F, b, h, d, isxn, t0n, TTn, lds0 + O_STG + (sbuf == 2 ? 0 : sbuf + 1) * STG_BYTES, wave); }
            if (ci >= 1)
        {
            int lane = F.lane; asm volatile("" : "+v"(lane));
            const int col = lane & 15, kb = lane >> 4;
            if (wave < 2) {
                const int sc = wave; LAS unsigned char* IMG = L + stgp + sc * IMG_SC; LAS unsigned char* AB0p = IMX_AB0P(pp, sc);
                f32x4 n4 = {0.f, 0.f, 0.f, 0.f}, x4 = n4, nt4 = n4;
                u32x2 a2_[4];
#pragma unroll
                for (int jt = 0; jt < 4; ++jt) a2_[jt] = trd(IMG + IMG_AT, 16 * jt, lane);
#pragma unroll
                for (int ks = 0; ks < 2; ++ks) { const bf16x8 fb = *(const LAS bf16x8*)(IMG + IMG_BT + col * 128 + (((4 * ks + kb) ^ (col & 7)) << 4)), fa = *(const LAS bf16x8*)(IMG + IMG_AT + col * 128 + (((4 * ks + kb) ^ (col & 7)) << 4)),
                                                              fk = *(const LAS bf16x8*)(IMG + IMG_KT + col * 128 + (((4 * ks + kb) ^ (col & 7)) << 4));
                    n4 = __builtin_amdgcn_mfma_f32_16x16x32_bf16(fb, fa, n4, 0, 0, 0);
                    nt4 = __builtin_amdgcn_mfma_f32_16x16x32_bf16(fa, fb, nt4, 0, 0, 0);
                    x4 = __builtin_amdgcn_mfma_f32_16x16x32_bf16(fa, fk, x4, 0, 0, 0); }
#pragma unroll
                for (int c = 0; c < 4; ++c) { if (!(4 * kb + c < col)) n4[c] = 0.f; if (!(col < 4 * kb + c)) { x4[c] = 0.f; nt4[c] = 0.f; } }
#define FRAG4(v) __builtin_bit_cast(bf16x8, (u32x4){pk2((v)[0], (v)[1]), pk2((v)[2], (v)[3]), 0u, 0u})
                const f32x4 z4 = {0.f, 0.f, 0.f, 0.f};
                f32x4 p4 = n4, pt4 = nt4, t4 = n4, tt4 = nt4;
#pragma unroll
                for (int c = 0; c < 4; ++c) if (4 * kb + c == col) { t4[c] += 1.f; tt4[c] += 1.f; }
#pragma unroll
                for (int lvl = 0; lvl < 3; ++lvl) {
                    const bf16x8 fp = FRAG4(p4), fpt = FRAG4(pt4);
                    p4 = __builtin_amdgcn_mfma_f32_16x16x32_bf16(fpt, fp, z4, 0, 0, 0);
                    pt4 = __builtin_amdgcn_mfma_f32_16x16x32_bf16(fp, fpt, z4, 0, 0, 0);
                    const bf16x8 fp2 = FRAG4(p4), ft = FRAG4(t4), ftt = FRAG4(tt4);
                    t4 = __builtin_amdgcn_mfma_f32_16x16x32_bf16(ftt, fp2, t4, 0, 0, 0);
                    if (lvl < 2) tt4 = __builtin_amdgcn_mfma_f32_16x16x32_bf16(fp2, ftt, tt4, 0, 0, 0);
                }
                const bf16x8 Tf = FRAG4(t4);
                const bf16x8 Xf = __builtin_bit_cast(bf16x8, (u32x4){pk2(x4[0], x4[1]), pk2(x4[2], x4[3]), 0u, 0u});
                const f32x4 ab = __builtin_amdgcn_mfma_f32_16x16x32_bf16(Xf, Tf, z4, 0, 0, 0);
                *(LAS u32x4*)(AB0p + (kb * 16 + col) * 16) = (u32x4){0u, 0u, pk2(ab[0], ab[1]), pk2(ab[2], ab[3])};
#pragma unroll
                for (int jt = 0; jt < 4; ++jt) { const u32x2 a2 = a2_[jt];
                    const bf16x8 Af = __builtin_bit_cast(bf16x8, (u32x4){a2.x, a2.y, 0u, 0u});
                    const f32x4 q = __builtin_amdgcn_mfma_f32_16x16x32_bf16(Af, Tf, z4, 0, 0, 0);
                    *(LAS u32x2*)(IMG + IMG_QT + (((jt >> 1) * 4 + kb) * 16 + col) * 16 + (jt & 1) * 8) = (u32x2){pk2(q[0], q[1]), pk2(q[2], q[3])}; }
            } else {
                const int sc = wave - 2; LAS unsigned char* IMG = L + stgp + sc * IMG_SC; LAS unsigned char* ABRp = IMX_ABRP(pp, sc);
#pragma unroll
                for (int which = 0; which < 2; ++which) {
                f32x4 d4 = {0.f, 0.f, 0.f, 0.f};
#pragma unroll
                for (int ks = 0; ks < 2; ++ks) { const bf16x8 fa = *(const LAS bf16x8*)(IMG + (which ? IMG_KT : IMG_BT) + col * 128 + (((4 * ks + kb) ^ (col & 7)) << 4)), fr_ = *(const LAS bf16x8*)(IMG + IMG_RT + col * 128 + (((4 * ks + kb) ^ (col & 7)) << 4));
                    d4 = __builtin_amdgcn_mfma_f32_16x16x32_bf16(fa, fr_, d4, 0, 0, 0); }
#pragma unroll
                for (int c = 0; c < 4; ++c) if (!(4 * kb + c <= col)) d4[c] = 0.f;
                *(LAS u32x2*)(ABRp + (kb * 16 + col) * 16 + which * 8) = (u32x2){pk2(d4[0], d4[1]), pk2(d4[2], d4[3])};
                }
            }
        }
            if (act && wave >= 2) {
#pragma unroll
                for (int mtt = 0; mtt < 2; ++mtt) { bf16x8 laf[8]; LORA_LOAD(laf, mtt, stg); LORA_TILE(laf, mtt, ci); } }
        }
        LDS_WAIT(); __builtin_amdgcn_s_barrier(); asm volatile("" ::: "memory");
        if (wave >= 4) {
            if (act) {
                u32x2 at2[2], rt2[2], bt2[2], kt2[2], bh2[2], kh2[2]; float rho2[2];
#pragma unroll
                for (int hr = 0; hr < 2; ++hr) { const int srow = srow0 + 16 * hr;
        {
            const int sc = srow >> 4, t = srow & 15; const int o = (srow * 64 + 4 * cq) * 4;
            gA[hr] = *(const LAS f32x4*)(L + O_G + o);
            const f32x4 av = *(const LAS f32x4*)(L + O_B + o), cl4 = *(const LAS f32x4*)(L + O_CL + o);
            f32x4 cp4 = *(const LAS f32x4*)(L + O_CL + (((t > 0 ? srow - 1 : srow)) * 64 + 4 * cq) * 4); if (t == 0) cp4 = (f32x4){0.f, 0.f, 0.f, 0.f};
            const f32x4 ka_w = *(const LAS f32x4*)(L + O_CT + (10 * 64 + 4 * cqv) * 4), rk_w = *(const LAS f32x4*)(L + O_CT + (11 * 64 + 4 * cqv) * 4);
            const f32x4 wc4 = *(const LAS f32x4*)(L + O_WC + (ci & 1) * 512 + (sc * 64 + 4 * cq) * 4);
            float rho = 0.f; f32x4 at, rt, bt, kt, bh, kh;
#pragma unroll
            for (int c = 0; c < 4; ++c) { const float kd = ksA[hr][c] * (1.f + (av[c] - 1.f) * ka_w[c]), bb = kkA[hr][c] * av[c]; rho += rsA[hr][c] * kd * rk_w[c];
                const float ec = __expf(cl4[c]), em = frcp(ec), ep = __expf(cp4[c]), eC = wc4[c] * em;
                at[c] = -kkA[hr][c] * ep; rt[c] = rsA[hr][c] * ec; bt[c] = bb * em; kt[c] = kd * em; bh[c] = bb * eC; kh[c] = kd * eC; }
            at2[hr] = PK4(at); rt2[hr] = PK4(rt); bt2[hr] = PK4(bt); kt2[hr] = PK4(kt); bh2[hr] = PK4(bh); kh2[hr] = PK4(kh);
            rho2[hr] = red16(rho);
        }
                }
#pragma unroll
                for (int hr = 0; hr < 2; ++hr) { const int srow = srow0 + 16 * hr;
        {
            const int sc = srow >> 4, t = srow & 15; const int swo = t * 128 + (((cq >> 1) ^ (t & 7)) << 4) + ((cq & 1) << 3);
            if (cq == 0) *(LAS float*)(L + O_RHO + (ci & 1) * 256 + srow * 4) = rho2[hr];
            LAS unsigned char* IMG = L + stg + sc * IMG_SC; LAS unsigned char* KHp = IMX_KHP(ci & 1, sc); LAS unsigned char* VRp = IMX_VRP(ci & 1, sc);
            *(LAS u32x2*)(IMG + IMG_AT + swo) = at2[hr]; *(LAS u32x2*)(IMG + IMG_RT + swo) = rt2[hr];
            *(LAS u32x2*)(IMG + IMG_BT + swo) = bt2[hr]; *(LAS u32x2*)(IMG + IMG_KT + swo) = kt2[hr];
            const int jt = cq >> 2, kb = cq & 3;
            *(LAS u32x2*)(IMG + IMG_RTP + (((jt >> 1) * 4 + kb) * 16 + t) * 16 + (jt & 1) * 8) = rt2[hr];
            *(LAS u32x2*)(IMG + IMG_BH + swo) = bh2[hr]; *(LAS u32x2*)(KHp + swo) = kh2[hr]; *(LAS u32x2*)(VRp + swo) = PK4(vsA[hr]);
        }
                }
            }
        } else if (ci >= 1)
        {
            int lane = F.lane; asm volatile("" : "+v"(lane));
            const int kb = lane >> 4, ig = 16 * wave + (lane & 15);
            bf16x8 fq_[2][2], fr_[2][2], fab0_[2], fabr_[2]; u32x2 bl_[2][4], kl_[2][4], vt_[2]; f32x4 wcv_[2][4];
#pragma unroll
            for (int sc = 0; sc < 2; ++sc) {
                const LAS unsigned char* IMG = L + stgp + sc * IMG_SC;
                vt_[sc] = trd(IMX_VRP(pp, sc), 16 * wave, lane);
#pragma unroll
                for (int ks = 0; ks < 2; ++ks) { fq_[sc][ks] = *(const LAS bf16x8*)(IMG + IMG_QT + (ks * 64 + lane) * 16); fr_[sc][ks] = *(const LAS bf16x8*)(IMG + IMG_RTP + (ks * 64 + lane) * 16); }
                fab0_[sc] = *(const LAS bf16x8*)(IMX_AB0P(pp, sc) + lane * 16); fabr_[sc] = *(const LAS bf16x8*)(IMX_ABRP(pp, sc) + lane * 16);
#pragma unroll
                for (int jt = 0; jt < 4; ++jt) { if (sc == 0) wcv_[0][jt] = *(const LAS f32x4*)(L + O_WC + pp * 512 + (16 * jt + 4 * kb) * 4); bl_[sc][jt] = trd(IMG + IMG_BH, 16 * jt, lane); kl_[sc][jt] = trd(IMX_KHP(pp, sc), 16 * jt, lane); }
            }
#pragma unroll
            for (int sc = 0; sc < 2; ++sc) {
                bf16x8 S0f[2];
                if (sc == 1) {
#pragma unroll
                    for (int jt = 0; jt < 4; ++jt) wcv_[1][jt] = *(const LAS f32x4*)(L + O_WC + pp * 512 + 256 + (16 * jt + 4 * kb) * 4); }
#pragma unroll
                for (int ks = 0; ks < 2; ++ks) S0f[ks] = __builtin_bit_cast(bf16x8, (u32x4){pk2(Sreg[2 * ks][0], Sreg[2 * ks][1]), pk2(Sreg[2 * ks][2], Sreg[2 * ks][3]), pk2(Sreg[2 * ks + 1][0], Sreg[2 * ks + 1][1]), pk2(Sreg[2 * ks + 1][2], Sreg[2 * ks + 1][3])});
                const u32x2 vt = vt_[sc];
                f32x4 sa = {0.f, 0.f, 0.f, 0.f}, y = sa;
#pragma unroll
                for (int ks = 0; ks < 2; ++ks) { sa = __builtin_amdgcn_mfma_f32_16x16x32_bf16(fq_[sc][ks], S0f[ks], sa, 0, 0, 0);
                                                 y = __builtin_amdgcn_mfma_f32_16x16x32_bf16(fr_[sc][ks], S0f[ks], y, 0, 0, 0); }
                sa = __builtin_amdgcn_mfma_f32_16x16x32_bf16(fab0_[sc], __builtin_bit_cast(bf16x8, (u32x4){0u, 0u, vt.x, vt.y}), sa, 0, 0, 0);
                const bf16x8 Bsv = __builtin_bit_cast(bf16x8, (u32x4){pk2(sa[0], sa[1]), pk2(sa[2], sa[3]), vt.x, vt.y});
                y = __builtin_amdgcn_mfma_f32_16x16x32_bf16(fabr_[sc], Bsv, y, 0, 0, 0);
#pragma unroll
                for (int c = 0; c < 4; ++c) *(LAS float*)(L + O_Y + ((16 * sc + 4 * kb + c) * 64 + ig) * 4) = y[c];
#pragma unroll
                for (int jt = 0; jt < 4; ++jt)
                    Sreg[jt] = __builtin_amdgcn_mfma_f32_16x16x32_bf16(__builtin_bit_cast(bf16x8, (u32x4){bl_[sc][jt].x, bl_[sc][jt].y, kl_[sc][jt].x, kl_[sc][jt].y}), Bsv, Sreg[jt] * wcv_[sc][jt], 0, 0, 0);
            }
        }

        if (wave < 4) asm volatile("s_waitcnt vmcnt(0)" ::: "memory");
        LDS_WAIT(); __builtin_amdgcn_s_barrier(); asm volatile("" ::: "memory");
#pragma unroll
        for (int hr = 0; hr < 2; ++hr) { g_p2[hr] = g_p1[hr]; g_p1[hr] = gA[hr]; }
        sbuf = sbuf == 2 ? 0 : sbuf + 1;
    }
    if (wave >= 4) {
        READOUT2(NCH - 1); }
    WAIT_BAR_ALL();
#undef VS_BACK
#undef IMX_KHP
#undef IMX_VRP
#undef IMX_AB0P
#undef IMX_ABRP
#undef READOUT
#undef READOUT2
#undef LORA_TILE
#undef LORA_LOAD
#undef CHUNK_GEOM
#undef PK4
}
}

namespace att {
constexpr int KVB = 64, NTILE = (CT + T) / KVB;
constexpr int KSLOT = 5120, VSLOT = 10240, VPITCH = 80, KPITCH = 80;
constexpr int NSLOT = 5;
constexpr int L_K = 0, L_V = NSLOT * KSLOT, L_WS = L_V + NSLOT * VSLOT, L_ST = L_WS + NWAVES * 256, L_END = L_ST + NWAVES * 8192;
static_assert(L_END <= MISC_OFF, "attention LDS");
typedef __attribute__((address_space(3))) const char* lds_cptr;
typedef short v4i16_t __attribute__((ext_vector_type(4)));
__device__ __forceinline__ int crow(int r, int hi) { return (r & 3) + 8 * (r >> 2) + 4 * hi; }
__device__ __forceinline__ s16x4 vtr(lds_cptr p) { return __builtin_bit_cast(s16x4, __builtin_amdgcn_ds_read_tr16_b64_v4i16((__attribute__((address_space(3))) v4i16_t*)p)); }
__device__ __forceinline__ unsigned cvtpk(float lo, float hi) { typedef float f2 __attribute__((ext_vector_type(2))); typedef __bf16 b2 __attribute__((ext_vector_type(2)));
    f2 v = {lo, hi}; b2 b = __builtin_convertvector(v, b2); return __builtin_bit_cast(unsigned, b); }

__device__ __forceinline__ int krow(int b, int key) { return key < CT ? M + b * CT + key : b * T + (key - CT); }

__device__ __forceinline__ float max3f(float a, float b, float c) { float r; asm("v_max3_f32 %0, %1, %2, %3" : "=v"(r) : "v"(a), "v"(b), "v"(c)); return r; }
__device__ __forceinline__ void glds16_sv(const unsigned char* sbase, unsigned voff, unsigned lds_dst) { unsigned keep;
    asm volatile("s_mov_b32 %0, m0\n\ts_mov_b32 m0, %3\n\ts_nop 0\n\tglobal_load_lds_dwordx4 %1, %2\n\ts_mov_b32 m0, %0" : "=&s"(keep) : "v"(voff), "s"(sbase), "s"(lds_dst) : "memory"); }
__device__ __forceinline__ void issue_k(Frame& F, const bf16*  , int b, int h, int m, int t, int slot, unsigned lds0) {
    if (F.wave < 5) { const unsigned char* sb = F.ws + WS_K8 + (size_t)(((b * 4 + h) * 2 + m) * NTILE + t) * KSLOT;
        glds16_sv(sb, (unsigned)(F.wave * 1024 + F.lane * 16), (unsigned)__builtin_amdgcn_readfirstlane(lds0 + L_K + slot * KSLOT + F.wave * 1024)); } }
__device__ __forceinline__ void issue_v(Frame& F, const bf16*  , int b, int h, int t, int slot, unsigned lds0) {
    const unsigned char* sb = F.ws + WS_VT8 + (size_t)((b * 4 + h) * NTILE + t) * VSLOT; const unsigned vo = (unsigned)(F.wave * 1024 + F.lane * 16);
    glds16_sv(sb, vo, (unsigned)__builtin_amdgcn_readfirstlane(lds0 + L_V + slot * VSLOT + F.wave * 1024));
    if (F.wave < 2) glds16_sv(sb + 8192, vo, (unsigned)__builtin_amdgcn_readfirstlane(lds0 + L_V + slot * VSLOT + 8192 + F.wave * 1024));
}

__device__ __forceinline__ void prime(Frame& F, int b, int h, int m) {
    const bf16* PKD = (const bf16*)(F.ws + WS_PX + 5 * U); const bf16* PVD = (const bf16*)(F.ws + WS_PX + 6 * U); const unsigned lds0 = (unsigned)(uintptr_t)F.lds;
    issue_k(F, PKD, b, h, m, 0, 0, lds0); issue_v(F, PVD, b, h, 0, 0, lds0); issue_k(F, PKD, b, h, m, 1, 1, lds0); issue_v(F, PVD, b, h, 1, 1, lds0); issue_k(F, PKD, b, h, m, 2, 2, lds0); issue_v(F, PVD, b, h, 2, 2, lds0); issue_k(F, PKD, b, h, m, 3, 3, lds0);
}
__device__ __forceinline__ void unit(Frame& F, int b, int h, int qb, float lam, bool primed, bool has_next, int nb, int nh) {
    const int lane = F.lane, wid = F.wave, r32 = lane & 31, hi = lane >> 5;
    LAS unsigned char* L = F.lds; const unsigned lds0 = (unsigned)(uintptr_t)L;
    const bf16* PQ = (const bf16*)(F.ws + WS_PX + 4 * U); const bf16* PKD = (const bf16*)(F.ws + WS_PX + 5 * U); const bf16* PVD = (const bf16*)(F.ws + WS_PX + 6 * U);
    bf16* OC = (bf16*)(F.ws + WS_OCAT);
    LAS float* wsf = (LAS float*)(L + L_WS) + wid * 64;
    LAS bf16* stash = (LAS bf16*)(L + L_ST + wid * 8192);
    const int qrow0 = b * T + qb * 256 + wid * 32;
    const lds_cptr kbase = (lds_cptr)L + L_K + r32 * KPITCH + hi * 32;
    const lds_cptr vbase = (lds_cptr)L + L_V + r32 * VPITCH + hi * 32;
    f32x16 o[4];
#pragma unroll 1
    for (int m = 0; m < 2; ++m) {
        if (m == 0 && !primed) prime(F, b, h, 0);
        pg8::i32x8_t q8;
#pragma unroll
        for (int i = 0; i < 4; ++i) { int lq_ = lane; asm volatile("" : "+v"(lq_));
            const u32x4 u = *(const u32x4*)(PQ + (size_t)(qrow0 + (lq_ & 31)) * 512 + h * 128 + m * 64 + 32 * (lq_ >> 5) + 8 * i);
            q8[2 * i] = (int)pk4f8(8.f * bflo(u.x), 8.f * bfhi(u.x), 8.f * bflo(u.y), 8.f * bfhi(u.y)); q8[2 * i + 1] = (int)pk4f8(8.f * bflo(u.z), 8.f * bfhi(u.z), 8.f * bflo(u.w), 8.f * bfhi(u.w)); }
#pragma unroll
        for (int d = 0; d < 4; ++d)
#pragma unroll
            for (int r = 0; r < 16; ++r) o[d][r] = 0.f;
        float mrun = 0.f;
        f32x16 lacc;
#pragma unroll
        for (int r = 0; r < 16; ++r) lacc[r] = 0.f;
        const pg8::i32x8_t ones8 = {0x38383838, 0x38383838, 0x38383838, 0x38383838, 0x38383838, 0x38383838, 0x38383838, 0x38383838};
        WAIT_BAR_ALL();
#define QKT_LOAD(kA_, kB_, ks_) do { const lds_cptr kp_ = kbase + (ks_) * KSLOT; \
            const pg8::i32x4_t ka_ = *(const __attribute__((address_space(3))) pg8::i32x4_t*)(kp_), kb_ = *(const __attribute__((address_space(3))) pg8::i32x4_t*)(kp_ + 16), \
                               kc_ = *(const __attribute__((address_space(3))) pg8::i32x4_t*)(kp_ + 32 * KPITCH), kd_ = *(const __attribute__((address_space(3))) pg8::i32x4_t*)(kp_ + 32 * KPITCH + 16); \
            kA_ = __builtin_shufflevector(ka_, kb_, 0, 1, 2, 3, 4, 5, 6, 7); kB_ = __builtin_shufflevector(kc_, kd_, 0, 1, 2, 3, 4, 5, 6, 7); } while (0)
#define QKT_MMA(P0, P1, kA_, kB_, C_) do { \
            P0 = __builtin_amdgcn_mfma_scale_f32_32x32x64_f8f6f4(kA_, q8, C_, 0, 0, 0, 0x7F7F7F7F, 0, 0x7F7F7F7F); \
            P1 = __builtin_amdgcn_mfma_scale_f32_32x32x64_f8f6f4(kB_, q8, C_, 0, 0, 0, 0x7F7F7F7F, 0, 0x7F7F7F7F); \
            asm volatile("" : "+v"(P0), "+v"(P1) : "v"(kA_), "v"(kB_));              \
            } while (0)
#define QKT(P0, P1, ks_, C_) do { pg8::i32x8_t kA__, kB__; QKT_LOAD(kA__, kB__, ks_); QKT_MMA(P0, P1, kA__, kB__, C_); } while (0)
#define ROWMAX(P0, P1, rm_) do { float a_ = max3f(P0[0], P0[1], P1[0]), b_ = max3f(P0[2], P0[3], P1[1]); a_ = max3f(a_, P1[2], P1[3]); \
            _Pragma("unroll") for (int r = 4; r < 16; r += 4) { a_ = max3f(a_, P0[r], P0[r + 1]); b_ = max3f(b_, P0[r + 2], P0[r + 3]); a_ = max3f(a_, P1[r], P1[r + 1]); b_ = max3f(b_, P1[r + 2], P1[r + 3]); } \
            rm_ = max3f(a_, b_, b_); { auto rr_ = __builtin_amdgcn_permlane32_swap(__float_as_uint(rm_), __float_as_uint(rm_), false, false); rm_ = max3f(__uint_as_float(rr_[0]), __uint_as_float(rr_[1]), __uint_as_float(rr_[1])); } } while (0)
        pg8::i32x8_t paA, paB;
        f32x16 pA0, pA1;
        const f32x16 z16 = {0.f, 0.f, 0.f, 0.f, 0.f, 0.f, 0.f, 0.f, 0.f, 0.f, 0.f, 0.f, 0.f, 0.f, 0.f, 0.f};
        QKT(pA0, pA1, 0, z16);
        asm volatile("s_nop 15\n\ts_nop 15\n\ts_nop 15\n\ts_nop 15\n\ts_nop 15\n\ts_nop 15\n\ts_nop 15\n\ts_nop 15\n\ts_nop 15\n\ts_nop 15" : "+v"(pA0), "+v"(pA1));
        f32x16 negm;
        { float rm; ROWMAX(pA0, pA1, rm); mrun = rm - 24.f;
#pragma unroll
          for (int r = 0; r < 16; ++r) { negm[r] = 56.5f - mrun; pA0[r] += negm[r]; pA1[r] += negm[r]; } }
#define PACKU8(dst_, X_, base_) do { _Pragma("unroll") for (int q = 0; q < 4; ++q) { unsigned w_ = 0u; _Pragma("unroll") for (int e = 0; e < 4; ++e) w_ = __builtin_amdgcn_cvt_pk_u8_f32(X_[4 * q + e], e, w_); dst_[(base_) + q] = (int)w_; } } while (0)
        PACKU8(paA, pA0, 0); PACKU8(paA, pA1, 4);
#define STEP(PAc, PAn, t_, MORE_, BAR_) do { const int tt_ = (t_); f32x16 N0, N1; \
              \
            if (BAR_) { \
            if (tt_ < NTILE - 3) { if (wid < 2) asm volatile("s_waitcnt vmcnt(3) lgkmcnt(0)\n\ts_barrier" ::: "memory"); else if (wid < 5) asm volatile("s_waitcnt vmcnt(2) lgkmcnt(0)\n\ts_barrier" ::: "memory"); \
                                   else asm volatile("s_waitcnt vmcnt(1) lgkmcnt(0)\n\ts_barrier" ::: "memory"); } \
            else asm volatile("s_waitcnt vmcnt(0) lgkmcnt(0)\n\ts_barrier" ::: "memory");        \
            } \
            const int s0_ = tt_ % 5  , s1_ = (tt_ + 1) % 5  , kw_ = (tt_ + 4) % 5  , vw_ = (tt_ + 3) % 5  ; \
            constexpr bool more_ = (MORE_); \
            pg8::i32x8_t kfA_, kfB_; if (more_) QKT_LOAD(kfA_, kfB_, s1_);        \
            if (tt_ + 4 < NTILE) issue_k(F, PKD, b, h, m, tt_ + 4, kw_, lds0); \
            if (tt_ + 3 < NTILE) issue_v(F, PVD, b, h, tt_ + 3, vw_, lds0); \
              \
            if (more_) QKT_MMA(N0, N1, kfA_, kfB_, negm); \
            const pg8::i32x8_t pa8_ = PAc;                         \
            const lds_cptr vp_ = vbase + s0_ * VSLOT; \
            float f_ = 1.f; bool resc_ = false; \
            pg8::i32x4_t vlo_[2], vhi_[2];                         \
            _Pragma("unroll") for (int gp = 0; gp < 2; ++gp) { vlo_[gp] = *(const __attribute__((address_space(3))) pg8::i32x4_t*)(vp_ + gp * 32 * VPITCH); vhi_[gp] = *(const __attribute__((address_space(3))) pg8::i32x4_t*)(vp_ + gp * 32 * VPITCH + 16); } \
            __builtin_amdgcn_sched_barrier(0); \
              \
            _Pragma("unroll") for (int g = 0; g < 4; ++g) { \
                const pg8::i32x8_t vb_ = __builtin_shufflevector(vlo_[g & 1], vhi_[g & 1], 0, 1, 2, 3, 4, 5, 6, 7); \
                o[g] = __builtin_amdgcn_mfma_scale_f32_32x32x64_f8f6f4(pa8_, vb_, o[g], 0, 0, 0, 0x7F7F7F7F, 0, 0x7F7F7F7F); \
                if (g == 3) lacc = __builtin_amdgcn_mfma_scale_f32_32x32x64_f8f6f4(pa8_, ones8, lacc, 0, 0, 0, 0x7F7F7F7F, 0, 0x7F7F7F7F); \
                if (g < 2) { vlo_[g & 1] = *(const __attribute__((address_space(3))) pg8::i32x4_t*)(vp_ + (g + 2) * 32 * VPITCH); vhi_[g & 1] = *(const __attribute__((address_space(3))) pg8::i32x4_t*)(vp_ + (g + 2) * 32 * VPITCH + 16); } \
                if (more_) { \
                    if (g == 1) { asm volatile("" : "+v"(N0), "+v"(N1) : "v"(o[0]), "v"(o[1]));        \
                        float rm_; ROWMAX(N0, N1, rm_);                       \
                        if (__any(rm_ > 120.5f)) { const float dl_ = fmaxf(rm_ - 80.5f, 0.f); f_ = __builtin_amdgcn_exp2f(-0.125f * dl_); resc_ = true; \
                            _Pragma("unroll") for (int r = 0; r < 16; ++r) { N0[r] -= dl_; N1[r] -= dl_; negm[r] -= dl_; } } } \
                    if (g == 2) { PACKU8(PAn, N0, 0); asm volatile("" : "+v"(PAn)); } \
                    if (g == 3) { PACKU8(PAn, N1, 4); asm volatile("" : "+v"(PAn)); } } \
                __builtin_amdgcn_sched_barrier(0); } \
            if (resc_) { asm volatile("s_nop 15\n\ts_nop 15\n\ts_nop 15\n\ts_nop 15\n\ts_nop 15\n\ts_nop 15\n\ts_nop 15\n\ts_nop 15" ::: "memory");     \
                if (hi == 0) wsf[r32] = f_; \
                LDS_WAIT(); asm volatile("" ::: "memory"); \
                _Pragma("unroll") for (int r = 0; r < 16; ++r) { const float fr_ = wsf[crow(r, hi)]; lacc[r] *= fr_; \
                    _Pragma("unroll") for (int d = 0; d < 4; ++d) o[d][r] *= fr_; } \
                LDS_WAIT(); asm volatile("" ::: "memory"); } \
        } while (0)
#pragma unroll 1
        for (int t = 0; t < NTILE - 2; t += 2) { STEP(paA, paB, t, true, true); STEP(paB, paA, t + 1, true, false); }
        STEP(paA, paB, NTILE - 2, true, true); STEP(paB, paA, NTILE - 1, false, false);
#undef STEP
#undef PACKU8
#undef QKT
#undef QKT_LOAD
#undef QKT_MMA
#undef ROWMAX
        WAIT_BAR_ALL();
        if (m == 0) prime(F, b, h, 1); else if (has_next) prime(F, nb, nh, 0);
        int lane_e = lane; asm volatile("" : "+v"(lane_e)); const int r32e = lane_e & 31, hie = lane_e >> 5;
        LAS bf16* stash_e = (LAS bf16*)(L + L_ST + wid * 8192); LAS float* wsf_e = (LAS float*)(L + L_WS) + wid * 64;
        float rl[16];
#pragma unroll
        for (int r = 0; r < 16; ++r) rl[r] = frcp(lacc[r]);
        (void)wsf_e;
        if (m == 0) {
#pragma unroll
            for (int r = 0; r < 16; ++r)
#pragma unroll
                for (int d = 0; d < 4; ++d) stash_e[crow(r, hie) * 128 + d * 32 + r32e] = (bf16)f2bf(o[d][r] * rl[r]);
            LDS_WAIT(); asm volatile("" ::: "memory");
        } else {
            const float* sub = F.in[I_SUBLN];
            float sw4[4];
#pragma unroll
            for (int d = 0; d < 4; ++d) sw4[d] = sub[d * 32 + r32e] * 0.8f;
            unsigned short o0h[16][4];
#pragma unroll
            for (int r = 0; r < 16; ++r)
#pragma unroll
                for (int d = 0; d < 4; ++d) o0h[r][d] = stash_e[crow(r, hie) * 128 + d * 32 + r32e];
            float ssv[16];
#pragma unroll
            for (int r = 0; r < 16; ++r) { float ss = 0.f;
#pragma unroll
                for (int d = 0; d < 4; ++d) { const float o0 = bflo((unsigned)o0h[r][d]); const float a = o0 - lam * (o[d][r] * rl[r]); o[d][r] = a; ss += a * a; }
                ssv[r] = red16(ss); }
#pragma unroll
            for (int r = 0; r < 16; ++r) ssv[r] += __builtin_bit_cast(float, __builtin_amdgcn_ds_swizzle(__builtin_bit_cast(int, ssv[r]), 0x401F));
#pragma unroll
            for (int r = 0; r < 16; ++r) { const float rinv = frsq(ssv[r] * (1.f / 128.f) + NORM_EPS);
#pragma unroll
                for (int d = 0; d < 4; ++d) o[d][r] = o[d][r] * rinv * sw4[d]; }
            LDS_WAIT(); asm volatile("" ::: "memory");
#pragma unroll
            for (int r = 0; r < 16; ++r)
#pragma unroll
                for (int d = 0; d < 4; ++d) stash_e[crow(r, hie) * 128 + d * 32 + r32e] = (bf16)f2bf(o[d][r]);
            LDS_WAIT(); asm volatile("" ::: "memory");
#pragma unroll
            for (int i = 0; i < 8; ++i) { const int row = i * 4 + (lane_e >> 4), chk = lane_e & 15;
                const u32x4 v = *(const LAS u32x4*)(stash_e + row * 128 + chk * 8);
                *(u32x2*)((unsigned char*)OC + (size_t)(qrow0 + row) * 1536 + 1024 + h * 128 + chk * 8) = (u32x2){pk4f8(bflo(v.x), bfhi(v.x), bflo(v.y), bfhi(v.y)), pk4f8(bflo(v.z), bfhi(v.z), bflo(v.w), bfhi(v.w))}; }
            LDS_WAIT(); asm volatile("" ::: "memory");
        }
    }
    WAIT_BAR_ALL();
}
}

__device__ __forceinline__ void phase_vt8(Frame& F) {
    const bf16* PVD = (const bf16*)(F.ws + WS_PX + 6 * U); unsigned char* VT = F.ws + WS_VT8;
    LAS unsigned char* Tl = F.lds + 16384 + F.wave * att::VSLOT;
    const int gw = F.vcu * NWAVES + F.wave, NGW = F.G * NWAVES, lane = F.lane;
    const int chunk = lane & 15, rq = lane >> 4;
    for (int it = gw; it < NB * 4 * att::NTILE; it += NGW) {
        const int b = it / (4 * att::NTILE), h = (it / att::NTILE) & 3, t = it % att::NTILE;
        u32x4 raw[16];
#pragma unroll
        for (int i = 0; i < 16; ++i) raw[i] = *(const u32x4*)(PVD + (size_t)att::krow(b, t * 64 + 4 * i + rq) * 512 + h * 128 + 8 * chunk);
#pragma unroll
        for (int i = 0; i < 16; ++i) {
            const int pos = (i & 1) * 32 + 16 * (i >> 3) + 4 * ((i & 7) >> 1) + rq;
            const u32x4 u = raw[i];
            const unsigned w0 = (unsigned)__builtin_amdgcn_cvt_pk_fp8_f32(bflo(u.x), bfhi(u.x), 0, false), w1 = (unsigned)__builtin_amdgcn_cvt_pk_fp8_f32(bflo(u.y), bfhi(u.y), 0, false),
                           w2 = (unsigned)__builtin_amdgcn_cvt_pk_fp8_f32(bflo(u.z), bfhi(u.z), 0, false), w3 = (unsigned)__builtin_amdgcn_cvt_pk_fp8_f32(bflo(u.w), bfhi(u.w), 0, false);
            LAS unsigned char* p = Tl + (8 * chunk) * att::VPITCH + pos;
            p[0 * att::VPITCH] = (unsigned char)(w0 & 255u); p[1 * att::VPITCH] = (unsigned char)((w0 >> 8) & 255u); p[2 * att::VPITCH] = (unsigned char)(w1 & 255u); p[3 * att::VPITCH] = (unsigned char)((w1 >> 8) & 255u);
            p[4 * att::VPITCH] = (unsigned char)(w2 & 255u); p[5 * att::VPITCH] = (unsigned char)((w2 >> 8) & 255u); p[6 * att::VPITCH] = (unsigned char)(w3 & 255u); p[7 * att::VPITCH] = (unsigned char)((w3 >> 8) & 255u);
        }
        LDS_WAIT(); asm volatile("" ::: "memory");
#pragma unroll
        for (int j = 0; j < 10; ++j) *(u32x4*)(VT + (size_t)it * att::VSLOT + (lane + 64 * j) * 16) = *(const LAS u32x4*)(Tl + (lane + 64 * j) * 16);
        LDS_WAIT(); asm volatile("" ::: "memory");
    }
}

#define X1ROW(out_, row_) ((const unsigned char*)(out_) + (size_t)(row_) * 4096 + 2048)
struct EpiWout {
    static constexpr bool PERM = true, AFTER_DRAIN = false;
    const float* x; float* out; const float* mod;
    __device__ __forceinline__ void operator()(const pg8::f32x4 (&acc)[2][2][4][2], const pg8::Unit& u, int wr, int wc, int fr, int fq) const {
        const int col0 = u.pn * 256 + wc * 32 + 8 * fq; const int b = (u.pm * 256) >> 12;
        f32x4 gv[2][2];
#pragma unroll
        for (int bj = 0; bj < 2; ++bj)
#pragma unroll
            for (int n = 0; n < 2; ++n) gv[bj][n] = *(const f32x4*)(mod + b * 6144 + 2048 + col0 + bj * 128 + n * 4) * (1.f / WO_SCALE);
#pragma unroll
        for (int ai = 0; ai < 2; ++ai)
#pragma unroll
            for (int mp = 0; mp < 2; ++mp) { f32x4 xv[2][2][2];
#pragma unroll
                for (int mm = 0; mm < 2; ++mm) { const size_t off = (size_t)(u.pm * 256 + ai * 128 + wr * 64 + (2 * mp + mm) * 16 + fr) * D + col0;
#pragma unroll
                    for (int bj = 0; bj < 2; ++bj)
#pragma unroll
                        for (int n = 0; n < 2; ++n) xv[mm][bj][n] = *(const f32x4*)(x + off + bj * 128 + n * 4); }
#pragma unroll
                for (int mm = 0; mm < 2; ++mm) { const int m = 2 * mp + mm; const size_t row = (size_t)(u.pm * 256 + ai * 128 + wr * 64 + m * 16 + fr);
#pragma unroll
                    for (int bj = 0; bj < 2; ++bj) { const f32x4 v0 = xv[mm][bj][0] + gv[bj][0] * acc[ai][bj][m][0], v1 = xv[mm][bj][1] + gv[bj][1] * acc[ai][bj][m][1];
                        *(u32x4*)((unsigned char*)out + row * 4096 + 2048 + (col0 + bj * 128) * 2) = (u32x4){pk2(v0[0], v0[1]), pk2(v0[2], v0[3]), pk2(v1[0], v1[1]), pk2(v1[2], v1[3])}; } } }
    }
};
struct EpiSwiGLU {
    static constexpr bool PERM = true, AFTER_DRAIN = false;
    bf16* hid;
    __device__ __forceinline__ void operator()(const pg8::f32x4 (&acc)[2][2][4][2], const pg8::Unit& u, int wr, int wc, int fr, int fq) const {
        const int ct = u.pn & 3; const int col0 = ct * 128 + wc * 32 + 8 * fq;
#pragma unroll
        for (int ai = 0; ai < 2; ++ai)
#pragma unroll
            for (int m = 0; m < 4; ++m) { const size_t row = (size_t)u.pm * 256 + ai * 128 + wr * 64 + m * 16 + fr;
                float hv[8];
#pragma unroll
                for (int n = 0; n < 2; ++n)
#pragma unroll
                    for (int j = 0; j < 4; ++j) { const float g = acc[ai][0][m][n][j] * (1.f / W1_SCALE), uu = acc[ai][1][m][n][j] * (1.f / W1_SCALE); const float hh = g * frcp(1.f + __expf(-g)) * uu;
                        hv[4 * n + j] = __builtin_amdgcn_fmed3f(hh, -448.f, 448.f); }
                *(u32x2*)((unsigned char*)hid + row * 512 + col0) = (u32x2){pk4f8(hv[0], hv[1], hv[2], hv[3]), pk4f8(hv[4], hv[5], hv[6], hv[7])}; }
    }
};
struct EpiYS {
    static constexpr bool PERM = true, AFTER_DRAIN = false;
    bf16* ys; const float* sw;
    __device__ __forceinline__ void operator()(const pg8::f32x4 (&acc)[2][2][4][2], const pg8::Unit& u, int wr, int wc, int fr, int fq) const {
        const int col0 = (u.pn & 3) * 256 + wc * 32 + 8 * fq;
#pragma unroll
        for (int ai = 0; ai < 2; ++ai)
#pragma unroll
            for (int m = 0; m < 4; ++m) { const size_t srow = (size_t)u.pm * 256 + ai * 128 + wr * 64 + m * 16 + fr;
#pragma unroll
                for (int bj = 0; bj < 2; ++bj) { f32x4 v0 = acc[ai][bj][m][0], v1 = acc[ai][bj][m][1];
#pragma unroll
                    for (int c = 0; c < 4; ++c) { v0[c] = __builtin_amdgcn_fmed3f(v0[c], -448.f, 448.f); v1[c] = __builtin_amdgcn_fmed3f(v1[c], -448.f, 448.f); }
                    *(u32x2*)((unsigned char*)ys + srow * 1024 + col0 + bj * 128) = (u32x2){pk4f8(v0[0], v0[1], v0[2], v0[3]), pk4f8(v1[0], v1[1], v1[2], v1[3])}; } }
    }
};
struct GroupedOrder {
    const LAS int* tstart;
    int rt_lo, nunits, G, c;
    __device__ __forceinline__ bool next(int i, pg8::Unit& u) const {
        const int Lx = i * G + c; if (Lx >= nunits) return false;
        const int rt = rt_lo + (Lx >> 2), ct = Lx & 3; int g = 0;
        for (int k = 32; k >= 1; k >>= 1) if (tstart[g + k] <= rt) g += k;
        while (tstart[g + 1] <= rt) ++g;
        u.pm = rt; u.pn = (g & 31) * 4 + ct; u.aux = g; return true;
    }
    __device__ __forceinline__ void a_ready(const pg8::Unit&) const {}
    __device__ __forceinline__ void done(const pg8::Unit&) const {}
    const int* stokg = nullptr;
    __device__ __forceinline__ int map_row(const pg8::Unit& u, int R) const { const int g = u.aux; const int pos = (u.pm - tstart[g]) * 256 + R; const bool in = pos < tstart[65 + g];
        const int tok = stokg[(size_t)g * GCAP + (in ? pos : 0)]; return in ? tok : M; }
};
constexpr int TS_OFF = 131072;
__device__ __forceinline__ void build_tstart(Frame& F) {
    LAS int* ts = (LAS int*)(F.lds + TS_OFF); const int* cnt = (const int*)(F.ws + WS_CTL);
    if (F.tid == 0) { int acc = 0; for (int g = 0; g < 64; ++g) { const int c = cnt[g * CNT_STRIDE]; ts[g] = acc; ts[65 + g] = c; acc += (c + 255) >> 8; } ts[64] = acc; }
    __syncthreads();
}

__device__ __forceinline__ void phase_router_generic(Frame& F) {
    LAS float* WL = (LAS float*)F.lds;
    LAS float* BL = (LAS float*)(F.lds + 36 * 1024 * 4);
    const float* WR = (const float*)(F.ws + WS_ROUT);
    for (int i = F.tid; i < 36 * 256; i += NTHR) ((LAS f32x4*)WL)[i] = ((const f32x4*)WR)[i];
    if (F.tid < 36) BL[F.tid] = F.tid < 4 ? F.in[I_BG][F.tid] : F.in[I_BE][F.tid - 4];
    __syncthreads();
    const int gw = F.vcu * NWAVES + F.wave, NGW = F.G * NWAVES, lane = F.lane;
    const float* mod = (const float*)(F.ws + WS_MOD); const float* nw = F.in[I_N2W];
    bf16* H2 = (bf16*)(F.ws + WS_H2); int* TI = (int*)(F.ws + WS_TI); float* TW = (float*)(F.ws + WS_TW); int* cnt = (int*)(F.ws + WS_CTL);
    if (gw == 0) { u32x4* z = (u32x4*)((unsigned char*)H2 + (size_t)M * D) + lane; z[0] = (u32x4){0u, 0u, 0u, 0u}; }
    int my_e = 0, my_row = -1; float my_w0 = 0.f, my_w1 = 0.f; int nparked = 0;
#define ROUTER_FLUSH() do { if (my_row >= 0) { const int ex0_ = my_e & 255, ex1_ = my_e >> 8; const int p0_ = atomicAdd(cnt + ex0_ * CNT_STRIDE, 1), p1_ = atomicAdd(cnt + (32 + ex1_) * CNT_STRIDE, 1); \
        TI[my_row * 4 + 0] = my_e; TI[my_row * 4 + 1] = p0_; TI[my_row * 4 + 2] = p1_; TW[my_row * 2 + 0] = my_w0; TW[my_row * 2 + 1] = my_w1; \
        int* SG_ = (int*)(F.ws + WS_STOKG); SG_[(size_t)ex0_ * GCAP + p0_] = my_row; SG_[(size_t)(32 + ex1_) * GCAP + p1_] = my_row; } my_row = -1; nparked = 0; } while (0)
    f32x4 vn[4];
    if (gw < M) {
#pragma unroll
        for (int j = 0; j < 4; ++j) { const u32x2 q = ((const u32x2*)X1ROW(F.out, gw) + lane)[64 * j]; vn[j] = (f32x4){bflo(q.x), bfhi(q.x), bflo(q.y), bfhi(q.y)}; } }
    for (int row = gw; row < M; row += NGW) {
        const int b = row >> 12;
        f32x4 v[4]; float s = 0.f;
#pragma unroll
        for (int j = 0; j < 4; ++j) v[j] = vn[j];
        if (row + NGW < M) {
#pragma unroll
            for (int j = 0; j < 4; ++j) { const u32x2 q = ((const u32x2*)X1ROW(F.out, row + NGW) + lane)[64 * j]; vn[j] = (f32x4){bflo(q.x), bfhi(q.x), bflo(q.y), bfhi(q.y)}; } }
#pragma unroll
        for (int j = 0; j < 4; ++j) s += (v[j].x * v[j].x + v[j].y * v[j].y) + (v[j].z * v[j].z + v[j].w * v[j].w);
        const float rinv = 1.f / sqrtf(wave_sum(s) * (1.f / D) + NORM_EPS);
        unsigned* o8 = (unsigned*)((unsigned char*)H2 + (size_t)row * D) + lane;
#pragma unroll
        for (int j = 0; j < 4; ++j) { const int k = 256 * j + 4 * lane;
            const f32x4 w = *(const f32x4*)(nw + k), sh = *(const f32x4*)(mod + b * 6144 + 3072 + k), scv = *(const f32x4*)(mod + b * 6144 + 4096 + k);
            v[j] = (v[j] * rinv) * w * (scv + 1.f) + sh;
            o8[64 * j] = pk4f8(v[j].x, v[j].y, v[j].z, v[j].w); }
        float gl[4];
#pragma unroll
        for (int e = 0; e < 4; ++e) { float a = 0.f;
#pragma unroll
            for (int j = 0; j < 4; ++j) { const f32x4 w = *(const LAS f32x4*)(WL + e * 1024 + 256 * j + 4 * lane); a += (v[j].x * w.x + v[j].y * w.y) + (v[j].z * w.z + v[j].w * w.w); }
            gl[e] = wave_sum(a) + BL[e]; }
        int gs = 0; float gm = gl[0];
#pragma unroll
        for (int e = 1; e < 4; ++e) if (gl[e] > gm) { gm = gl[e]; gs = e; }
        float den = 0.f;
#pragma unroll
        for (int e = 0; e < 4; ++e) den += __expf(gl[e] - gm);
        const float gprob = 1.f / den;
        float el[8];
#pragma unroll
        for (int e = 0; e < 8; ++e) { float a = 0.f; const LAS float* wp = WL + (4 + gs * 8 + e) * 1024;
#pragma unroll
            for (int j = 0; j < 4; ++j) { const f32x4 w = *(const LAS f32x4*)(wp + 256 * j + 4 * lane); a += (v[j].x * w.x + v[j].y * w.y) + (v[j].z * w.z + v[j].w * w.w); }
            el[e] = wave_sum(a) + BL[4 + gs * 8 + e]; }
        int i0 = 0; float v0 = el[0];
#pragma unroll
        for (int e = 1; e < 8; ++e) if (el[e] > v0) { v0 = el[e]; i0 = e; }
        int i1 = -1; float v1 = -3.0e38f;
#pragma unroll
        for (int e = 0; e < 8; ++e) if (e != i0 && el[e] > v1) { v1 = el[e]; i1 = e; }
        const float e1 = __expf(v1 - v0); const float w0 = gprob / (1.f + e1), w1 = gprob * e1 / (1.f + e1);
        if (lane == nparked) { my_e = (gs * 8 + i0) | ((gs * 8 + i1) << 8); my_row = row; my_w0 = w0; my_w1 = w1; }
        if (++nparked == 64) ROUTER_FLUSH();
    }
    ROUTER_FLUSH();
#undef ROUTER_FLUSH
}
__device__ __forceinline__ void phase_router(Frame& F) {
    if (F.G != 256) { phase_router_generic(F); return; }
    LAS float* WL = (LAS float*)F.lds;
    LAS float* BL = (LAS float*)(F.lds + 36 * 1024 * 4);
    LAS float* CS = (LAS float*)(F.lds + 36 * 1024 * 4 + 256); LAS float* SH = CS + 1024;
    const float* WR = (const float*)(F.ws + WS_ROUT); const float* mod = (const float*)(F.ws + WS_MOD); const float* nw = F.in[I_N2W];
    const int b = F.vcu >> 4, lane = F.lane;
    { f32x4 wq[18];
#pragma unroll
      for (int q = 0; q < 18; ++q) wq[q] = ((const f32x4*)WR)[F.tid + q * NTHR];
#pragma unroll
      for (int q = 0; q < 18; ++q) ((LAS f32x4*)WL)[F.tid + q * NTHR] = wq[q]; }
    if (F.tid < 36) BL[F.tid] = F.tid < 4 ? F.in[I_BG][F.tid] : F.in[I_BE][F.tid - 4];
    for (int i = F.tid; i < 1024; i += NTHR) { CS[i] = nw[i] * (1.f + mod[b * 6144 + 4096 + i]); SH[i] = mod[b * 6144 + 3072 + i]; }
    __syncthreads();
    bf16* H2 = (bf16*)(F.ws + WS_H2); int* TI = (int*)(F.ws + WS_TI); float* TW = (float*)(F.ws + WS_TW); int* cnt = (int*)(F.ws + WS_CTL);
    if (F.vcu == 0 && F.wave == 0) { u32x4* z = (u32x4*)((unsigned char*)H2 + (size_t)M * D) + lane; z[0] = (u32x4){0u, 0u, 0u, 0u}; }
    const int rg = lane >> 4, kl = lane & 15;
    const int rbase = F.vcu * 256 + F.wave * 32;
    int my_e = 0, my_row = -1; float my_w0 = 0.f, my_w1 = 0.f;
#pragma unroll 1
    for (int it = 0; it < 8; ++it) {
        const int row = rbase + 4 * it + rg;
        int klv = kl; asm volatile("" : "+v"(klv));
        f32x4 v[16]; float s = 0.f;
#pragma unroll
        for (int j = 0; j < 16; ++j) { const u32x2 q = ((const u32x2*)X1ROW(F.out, row) + klv)[16 * j]; v[j] = (f32x4){bflo(q.x), bfhi(q.x), bflo(q.y), bfhi(q.y)}; }
#pragma unroll
        for (int j = 0; j < 16; ++j) s += (v[j].x * v[j].x + v[j].y * v[j].y) + (v[j].z * v[j].z + v[j].w * v[j].w);
        const float rinv = frsq(red16(s) * (1.f / D) + NORM_EPS);
        int rowv = row; asm volatile("" : "+v"(rowv) :: "memory");
        unsigned* o8 = (unsigned*)((unsigned char*)H2 + (size_t)rowv * D) + klv;
#pragma unroll
        for (int j = 0; j < 16; ++j) { const f32x4 c4 = *(const LAS f32x4*)(CS + 64 * j + 4 * klv), s4 = *(const LAS f32x4*)(SH + 64 * j + 4 * klv);
            v[j] = (v[j] * rinv) * c4 + s4;
            o8[16 * j] = pk4f8(v[j].x, v[j].y, v[j].z, v[j].w); }
#define RT_DOT(acc_, wp_) do { float a_ = 0.f; _Pragma("unroll") for (int hh_ = 0; hh_ < 2; ++hh_) { f32x4 w_[8]; \
            _Pragma("unroll") for (int j = 0; j < 8; ++j) w_[j] = *(const LAS f32x4*)((wp_) + 64 * (8 * hh_ + j) + 4 * klv); \
            asm volatile("" :: "v"(w_[0]), "v"(w_[1]), "v"(w_[2]), "v"(w_[3]), "v"(w_[4]), "v"(w_[5]), "v"(w_[6]), "v"(w_[7])); \
            _Pragma("unroll") for (int j = 0; j < 8; ++j) { const f32x4 x_ = v[8 * hh_ + j]; a_ += (x_.x * w_[j].x + x_.y * w_[j].y) + (x_.z * w_[j].z + x_.w * w_[j].w); } } (acc_) = a_; } while (0)
        float gl[4];
#pragma unroll
        for (int e = 0; e < 4; ++e) { float a; RT_DOT(a, WL + e * 1024); gl[e] = red16(a) + BL[e]; }
        int gs = 0; float gm = gl[0];
#pragma unroll
        for (int e = 1; e < 4; ++e) if (gl[e] > gm) { gm = gl[e]; gs = e; }
        float den = 0.f;
#pragma unroll
        for (int e = 0; e < 4; ++e) den += __expf(gl[e] - gm);
        const float gprob = frcp(den);
        float el[8];
#pragma unroll
        for (int e = 0; e < 8; ++e) { float a; const LAS float* wp = WL + (4 + gs * 8 + e) * 1024; RT_DOT(a, wp); el[e] = red16(a) + BL[4 + gs * 8 + e]; }
#undef RT_DOT
        int i0 = 0; float v0 = el[0];
#pragma unroll
        for (int e = 1; e < 8; ++e) if (el[e] > v0) { v0 = el[e]; i0 = e; }
        int i1 = -1; float v1 = -3.0e38f;
#pragma unroll
        for (int e = 0; e < 8; ++e) if (e != i0 && el[e] > v1) { v1 = el[e]; i1 = e; }
        const float e1 = __expf(v1 - v0); const float r1 = frcp(1.f + e1); const float w0 = gprob * r1, w1 = gprob * e1 * r1;
        if (kl == it) { my_e = (gs * 8 + i0) | ((gs * 8 + i1) << 8); my_row = row; my_w0 = w0; my_w1 = w1; }
    }
    LAS int* lc = (LAS int*)(F.lds + 36 * 1024 * 4 + 256 + 8192);
    __syncthreads();
    const int tidp = F.wave * 64 + pg8::lane_id_rebuilt();
    if (tidp < 64) lc[tidp] = 0;
    __syncthreads();
    int lp0 = 0, lp1 = 0; const int ex0 = my_e & 255, ex1 = my_e >> 8;
    if (my_row >= 0) { lp0 = atomicAdd((int*)(lc + ex0), 1); lp1 = atomicAdd((int*)(lc + 32 + ex1), 1); }
    __syncthreads();
    if (tidp < 64) { const int c = lc[tidp]; lc[64 + tidp] = c ? atomicAdd(cnt + tidp * CNT_STRIDE, c) : 0; }
    __syncthreads();
    if (my_row >= 0) { const int p0 = lc[64 + ex0] + lp0, p1 = lc[64 + 32 + ex1] + lp1;
        TI[my_row * 4 + 0] = my_e; TI[my_row * 4 + 1] = p0; TI[my_row * 4 + 2] = p1; TW[my_row * 2 + 0] = my_w0; TW[my_row * 2 + 1] = my_w1;
        int* SG = (int*)(F.ws + WS_STOKG); SG[(size_t)ex0 * GCAP + p0] = my_row; SG[(size_t)(32 + ex1) * GCAP + p1] = my_row; }
}
__device__ __forceinline__ void phase_dispatch(Frame& F) {
    build_tstart(F);
    const LAS int* ts = (const LAS int*)(F.lds + TS_OFF);
    const int* TI = (const int*)(F.ws + WS_TI); const float* TW = (const float*)(F.ws + WS_TW); int* STOK = (int*)(F.ws + WS_STOK); float* SW = (float*)(F.ws + WS_SW); const int* cnt = (const int*)(F.ws + WS_CTL);
    for (int row = F.bid * NTHR + F.tid; row < M; row += F.G * NTHR) {
        const int ee = TI[row * 4 + 0], p0 = TI[row * 4 + 1], p1 = TI[row * 4 + 2];
        const int s0 = ts[ee & 255] * 256 + p0, s1 = ts[32 + (ee >> 8)] * 256 + p1;
        STOK[s0] = row; STOK[s1] = row; SW[s0] = TW[row * 2]; SW[s1] = TW[row * 2 + 1];
    }
    for (int g = 0; g < 64; ++g) { const int c = ts[65 + g], base = ts[g] * 256, n = ((c + 255) & ~255) - c;
        for (int i = F.bid * NTHR + F.tid; i < n; i += F.G * NTHR) { STOK[base + c + i] = M; SW[base + c + i] = 0.f; } }
}
__device__ __forceinline__ void phase_combine(Frame& F) {
    build_tstart(F);
    const LAS int* ts = (const LAS int*)(F.lds + TS_OFF);
    const int gw = F.vcu * NWAVES + F.wave, NGW = F.G * NWAVES, lane = F.lane;
    const int* TI = (const int*)(F.ws + WS_TI); const bf16* YS = (const bf16*)(F.ws + WS_HG); const float* mod = (const float*)(F.ws + WS_MOD); const float* TW = (const float*)(F.ws + WS_TW);
    typedef int i32x4 __attribute__((ext_vector_type(4)));
    const int per = (M + NGW - 1) / NGW, r0 = gw * per, r1 = (r0 + per < M) ? r0 + per : M;
    f32x4 g2r[4]; int cur_b = -1;
    u32x4 yA0, yB0, yA1, yB1, yA2, yB2, x0[2], x1[2], x2[2];
    typedef float f32x2_ __attribute__((ext_vector_type(2)));
#define CMB_LOAD(yA_, yB_, xo_, i_) do { const size_t s0_ = (size_t)__builtin_amdgcn_readlane(s0L, (i_)), s1_ = (size_t)__builtin_amdgcn_readlane(s1L, (i_)); const size_t row_ = (size_t)(sg + (i_)); \
        xo_[0] = ((const u32x4*)X1ROW(F.out, row_) + 2 * lane)[0]; xo_[1] = ((const u32x4*)X1ROW(F.out, row_) + 2 * lane)[1]; \
        asm volatile("" ::: "memory");                          \
        yA_ = ((const u32x4*)((const unsigned char*)YS + s0_ * 1024) + lane)[0]; yB_ = ((const u32x4*)((const unsigned char*)YS + s1_ * 1024) + lane)[0]; } while (0)
#define CMB_PROC(yA_, yB_, xo_, i_) do { const int row_ = sg + (i_); const int b_ = row_ >> 12; \
        if (b_ != cur_b) { cur_b = b_; _Pragma("unroll") for (int q = 0; q < 4; ++q) g2r[q] = ((const f32x4*)(mod + b_ * 6144 + 5120) + 4 * lane)[q]; \
            _Pragma("unroll") for (int j = 0; j < 4; ++j) asm volatile("" : "+v"(g2r[j])); }     \
        const float tw0_ = __uint_as_float(__builtin_amdgcn_readlane(__float_as_uint(twL.x), (i_))) * (1.f / W2_SCALE), tw1_ = __uint_as_float(__builtin_amdgcn_readlane(__float_as_uint(twL.y), (i_))) * (1.f / W2_SCALE); \
        f32x4* o_ = (f32x4*)(F.out + (size_t)row_ * D) + 4 * lane; \
        _Pragma("unroll") for (int q = 0; q < 4; ++q) { const int aw = (int)(yA_)[q], cw = (int)(yB_)[q]; \
            const f32x2_ a01 = __builtin_amdgcn_cvt_pk_f32_fp8(aw, false), a23 = __builtin_amdgcn_cvt_pk_f32_fp8(aw, true), c01 = __builtin_amdgcn_cvt_pk_f32_fp8(cw, false), c23 = __builtin_amdgcn_cvt_pk_f32_fp8(cw, true); \
            const u32x4 xb = xo_[q >> 1]; const unsigned xw0 = (q & 1) ? xb.z : xb.x, xw1 = (q & 1) ? xb.w : xb.y; \
            const f32x4 xv = {bflo(xw0), bfhi(xw0), bflo(xw1), bfhi(xw1)}; \
            const f32x4 mo = {tw0_ * a01.x + tw1_ * c01.x, tw0_ * a01.y + tw1_ * c01.y, tw0_ * a23.x + tw1_ * c23.x, tw0_ * a23.y + tw1_ * c23.y}; \
            o_[q] = xv + g2r[q] * mo; } } while (0)
    for (int sg = r0; sg < r1; sg += 64) {
        const int n = r1 - sg < 64 ? r1 - sg : 64;
        i32x4 tiL = {0, 0, 0, 0}; f32x2 twL = {0.f, 0.f};
        if (lane < n) { tiL = *(const i32x4*)(TI + (size_t)(sg + lane) * 4); twL = *(const f32x2*)(TW + (size_t)(sg + lane) * 2); }
        const int s0L = ts[tiL.x & 255] * 256 + tiL.y, s1L = ts[32 + ((tiL.x >> 8) & 31)] * 256 + tiL.z;
        int i = 0;
        if (n >= 5) {
            CMB_LOAD(yA0, yB0, x0, 0); CMB_LOAD(yA1, yB1, x1, 1);
#pragma unroll 1
            for (; i + 4 < n; i += 3) { CMB_LOAD(yA2, yB2, x2, i + 2); CMB_PROC(yA0, yB0, x0, i); CMB_LOAD(yA0, yB0, x0, i + 3); CMB_PROC(yA1, yB1, x1, i + 1); CMB_LOAD(yA1, yB1, x1, i + 4); CMB_PROC(yA2, yB2, x2, i + 2); }
        } else { if (0 < n) CMB_LOAD(yA0, yB0, x0, 0); if (1 < n) CMB_LOAD(yA1, yB1, x1, 1); }
#pragma unroll 1
        for (; i < n; i += 3) {
            if (i + 2 < n) CMB_LOAD(yA2, yB2, x2, i + 2);
            CMB_PROC(yA0, yB0, x0, i);
            if (i + 1 < n) { if (i + 3 < n) CMB_LOAD(yA0, yB0, x0, i + 3); CMB_PROC(yA1, yB1, x1, i + 1); }
            if (i + 2 < n) { if (i + 4 < n) CMB_LOAD(yA1, yB1, x1, i + 4); CMB_PROC(yA2, yB2, x2, i + 2); }
        }
    }
#undef CMB_LOAD
#undef CMB_PROC
}

constexpr int NPHASE = 11;
constexpr int DUP = 0;
__global__ void __launch_bounds__(NTHR, 2) fwd(Args args) {
    extern __shared__ __attribute__((aligned(16))) unsigned char lds_raw[];
    cg::grid_group grid = cg::this_grid();
    Frame F;
    int wave0 = __builtin_amdgcn_readfirstlane((int)threadIdx.x >> 6); asm volatile("" : "+s"(wave0));
    F.lds = (LAS unsigned char*)lds_raw; F.wave = wave0; F.lane = pg8::lane_id(); F.tid = wave0 * 64 + F.lane;
    F.G = gridDim.x; F.bid = blockIdx.x; F.vcu = (F.G % 8 == 0) ? (F.bid % 8) * (F.G / 8) + F.bid / 8 : F.bid;
    F.in = args.in; F.out = args.out; F.ws = args.ws;
    const int lo = args.ph_lo, hi = args.ph_hi;
#define REFRESH() do { int w_ = wave0; asm volatile("" : "+s"(w_)); F.wave = w_; F.lane = pg8::lane_id(); F.tid = w_ * 64 + F.lane; } while (0)
#define REFRESH_LATE() do { int w_ = wave0; asm volatile("" : "+s"(w_)); F.wave = w_; F.lane = pg8::lane_id_rebuilt(); F.tid = w_ * 64 + F.lane; } while (0)
#define IN(k) (lo <= (k) && (k) < hi)
    if (F.tid < 16) ((LAS unsigned*)(F.lds + MISC_OFF))[F.tid] = 0u;
    __syncthreads();
    XcdBarrier bar = xcd_barrier_post((unsigned*)(F.ws + WS_CTL) + CW_BAR, (volatile LAS unsigned*)(F.lds + MISC_OFF), wave0);
    if (lo < 0) grid.sync();
#define SEAM(k) do { if (IN(k) && IN((k) + 1)) xcd_barrier(bar); } while (0)
    if (IN(0)) { REFRESH(); for (int rep = 0; rep < (DUP == 6 ? 2 : 1); ++rep) { phase_mod(F); phase_convert(F); __syncthreads(); } } SEAM(0);
    if (IN(1)) { REFRESH(); for (int rep = 0; rep < (DUP == 6 ? 2 : 1); ++rep) phase_norm1(F); } SEAM(1);
    if (IN(2)) { REFRESH();
        { pg8::Gemm g{(const pg8::bf16_t*)(F.ws + WS_HX), (const pg8::bf16_t*)(F.ws + WS_WIN), MT, 2048, D, nullptr, F.wave}; pg8::StaticOrder S; S.init(MT, 2048, F.G, F.bid);
          pg8::EpiBf16<0, true> E{(pg8::bf16_t*)(F.ws + WS_PX), 512, nullptr, 512, U / 2, 1.f, 1.f, 4, M, 12, 8};
          pg8::gemm_phase<pg8::EpiBf16<0, true>, pg8::StaticOrder, true, true>(F.lds, g, S, E); if (DUP == 3) { __syncthreads(); pg8::gemm_phase<pg8::EpiBf16<0, true>, pg8::StaticOrder, true, true>(F.lds, g, S, E); } }
        __syncthreads();
        { pg8::Gemm g{(const pg8::bf16_t*)(F.ws + WS_HX8), (const pg8::bf16_t*)(F.ws + WS_WIN8), MT, 1536, D / 2, nullptr, F.wave}; pg8::StaticOrder S; S.init(MT, 1536, F.G, F.G - 1 - F.bid);
          pg8::EpiBf16<0> E{(pg8::bf16_t*)(F.ws + WS_PX + 4 * U), 512, nullptr, 512, U / 2, 1.f, 1.f / WI_SCALE};
          pg8::gemm_phase<pg8::EpiBf16<0>, pg8::StaticOrder, true, true, false, true>(F.lds, g, S, E); if (DUP == 3) { __syncthreads(); pg8::gemm_phase<pg8::EpiBf16<0>, pg8::StaticOrder, true, true, false, true>(F.lds, g, S, E); } }
    } SEAM(2);
    if (IN(3)) { REFRESH(); phase_prep(F); phase_vt8(F); } SEAM(3);
    if (IN(4)) { REFRESH();
        for (int rep = 0; rep < (DUP == 1 ? 2 : 1); ++rep) for (int s = F.bid; s < 256; s += F.G) scan::run(F, s);
        REFRESH_LATE();
        float lam;
        { const float s1 = wave_sum(F.in[I_LQ1][F.lane] * F.in[I_LK1][F.lane]), s2 = wave_sum(F.in[I_LQ2][F.lane] * F.in[I_LK2][F.lane]); lam = __expf(s1) - __expf(s2) + 0.2f; }
        for (int rep = 0; rep < (DUP == 2 ? 2 : 1); ++rep)
        if (F.G == 256) { for (int i = 0; i < 4; ++i) { const int u = F.vcu * 4 + i, un = u + 1; att::unit(F, u >> 6, (u >> 4) & 3, u & 15, lam, i > 0, i < 3, un >> 6, (un >> 4) & 3); } }
        else for (int u = F.bid; u < 1024; u += F.G) { const int un = u + F.G; att::unit(F, u >> 6, (u >> 4) & 3, u & 15, lam, u != F.bid, un < 1024, un >> 6, (un >> 4) & 3); }
    } SEAM(4);
    if (IN(5)) { REFRESH_LATE(); pg8::Gemm g{(const pg8::bf16_t*)(F.ws + WS_OCAT), (const pg8::bf16_t*)(F.ws + WS_WOUT), M, D, 1536 / 2, nullptr, F.wave}; pg8::StaticOrder S; S.init(M, D, F.G, F.bid);
        EpiWout E{F.in[I_X], F.out, (const float*)(F.ws + WS_MOD)};
        pg8::gemm_phase<EpiWout, pg8::StaticOrder, true, true, false, true>(F.lds, g, S, E); if (DUP == 3) { __syncthreads(); pg8::gemm_phase<EpiWout, pg8::StaticOrder, true, true, false, true>(F.lds, g, S, E); } } SEAM(5);
    if (IN(6)) { REFRESH_LATE(); phase_router(F); }
    if (IN(6) && IN(8)) xcd_barrier(bar);
    if (IN(8)) { REFRESH_LATE(); build_tstart(F); const LAS int* ts = (const LAS int*)(F.lds + TS_OFF);
        pg8::Gemm g{(const pg8::bf16_t*)(F.ws + WS_H2), (const pg8::bf16_t*)(F.ws + WS_B1), MAXSLOT, 32 * 1024, D / 2, (const int*)(F.ws + WS_STOK), F.wave};
        GroupedOrder S{ts, 0, ts[64] * 4, F.G, F.vcu, (const int*)(F.ws + WS_STOKG)}; EpiSwiGLU E{(bf16*)(F.ws + WS_HID)};
        pg8::gemm_phase<EpiSwiGLU, GroupedOrder, true, true, true, true>(F.lds, g, S, E); } SEAM(8);
    if (IN(9)) { REFRESH_LATE(); build_tstart(F); const LAS int* ts = (const LAS int*)(F.lds + TS_OFF);
        pg8::Gemm g{(const pg8::bf16_t*)(F.ws + WS_HID), (const pg8::bf16_t*)(F.ws + WS_B2), MAXSLOT, 32 * 1024, 256, nullptr, F.wave};
        GroupedOrder S{ts, 0, ts[64] * 4, F.G, F.vcu}; EpiYS E{(bf16*)(F.ws + WS_HG), (const float*)(F.ws + WS_SW)};
        pg8::gemm_phase<EpiYS, GroupedOrder, true, true, false, true>(F.lds, g, S, E); } SEAM(9);
    if (IN(10)) { REFRESH_LATE(); phase_combine(F); }
#undef IN
#undef SEAM
}

extern "C" void kernel_launch(void* const* d_in, const int* in_sizes, int n_in, void* d_out, int out_size, void* d_ws, size_t ws_size, hipStream_t stream) {
    static int grid = 0;
    if (grid == 0) {
        int dev = 0, cus = 0, per_cu = 0;
        hipGetDevice(&dev);
        hipDeviceGetAttribute(&cus, hipDeviceAttributeMultiprocessorCount, dev);
        hipFuncSetAttribute((const void*)fwd, hipFuncAttributeMaxDynamicSharedMemorySize, LDS_BYTES);
        hipOccupancyMaxActiveBlocksPerMultiprocessor(&per_cu, (const void*)fwd, NTHR, LDS_BYTES);
        if (n_in != 35 || ws_size < WS_END || per_cu < 1) { fprintf(stderr, "kernel_launch: unexpected n_in %d / ws %zu / per_cu %d\n", n_in, ws_size, per_cu); }
        grid = cus;
        (void)hipGetLastError();
    }
    hipMemsetAsync((char*)d_ws + WS_CTL, 0, CTL_BYTES, stream);
    Args a{};
    for (int i = 0; i < 35; ++i) a.in[i] = (const float*)d_in[i];
    a.out = (float*)d_out; a.ws = (unsigned char*)d_ws; a.ph_lo = 0; a.ph_hi = NPHASE;
    void* kargs[] = {&a};
    hipError_t e = hipLaunchCooperativeKernel((const void*)fwd, dim3(grid), dim3(NTHR), kargs, LDS_BYTES, stream);
    if (e != hipSuccess) fprintf(stderr, "cooperative launch failed: %s (grid %d)\n", hipGetErrorString(e), grid);
}
```
